# Optimizing an MI355X kernel written in HIP

```python
import jax
import jax.numpy as jnp
from jax import lax
import numpy as np

D_MODEL = 1024
BATCH = 4
SEQ = 8192
DEPTH = 1

GRID_W = 64
CTX_LEN = 256
N_HEADS = 8
HEAD_DIM = 64
ATTN_WIDTH = N_HEADS * HEAD_DIM
POOL_WINDOWS = (2, 4, 8, 16)
N_POOL_GROUPS = len(POOL_WINDOWS)
POOL_WIDTH = 512
POOL_GROUP = POOL_WIDTH // N_POOL_GROUPS
GATE_WIDTH = 2 * D_MODEL
IN_COLS = 3 * ATTN_WIDTH + POOL_WIDTH + GATE_WIDTH
WIN_ROWS = 8
WIN_COLS = 16
Q_COL_BLOCK = 16
K_COL_BLOCK = Q_COL_BLOCK + WIN_COLS
ROPE_FREQS = HEAD_DIM // 4
ROPE_THETA = 10000.0
D_FF = -(-8 * D_MODEL // (3 * 256)) * 256
N_MOD = 6
EPS = 1e-6
NEG_INF = -1e30

kernel_name = 'hybrid_natten_multipool_block'


def rms_norm(x, g):
    xf = x.astype(jnp.float32)
    y = xf * lax.rsqrt(jnp.mean(xf * xf, axis=-1, keepdims=True) + EPS)
    return (y * g.astype(jnp.float32)).astype(x.dtype)


def modulate(x, shift, scale):
    return x * (1.0 + scale) + shift


def heads(t):
    return t.reshape(*t.shape[:-1], N_HEADS, HEAD_DIM)


def split_projection(proj):
    a = ATTN_WIDTH
    q = proj[..., :a]
    k = proj[..., a:2 * a]
    v = proj[..., 2 * a:3 * a]
    p = proj[..., 3 * a:3 * a + POOL_WIDTH]
    gates = proj[..., 3 * a + POOL_WIDTH:]
    return q, k, v, p, gates


def axial_rope_tables(n_tok):
    t = jnp.arange(n_tok)
    pos = jnp.stack([t // GRID_W, t % GRID_W], axis=-1).astype(jnp.float32)
    inv = ROPE_THETA ** (-jnp.arange(ROPE_FREQS, dtype=jnp.float32) / ROPE_FREQS)
    ang = pos[:, :, None] * inv
    return jnp.cos(ang), jnp.sin(ang)


def apply_rope(x, cos, sin):
    b, s, h, dh = x.shape
    xf = x.astype(jnp.float32).reshape(b, s, h, 2, 2, ROPE_FREQS)
    x1, x2 = xf[..., 0, :], xf[..., 1, :]
    cs, sn = cos[:, None], sin[:, None]
    out = jnp.stack([x1 * cs - x2 * sn, x2 * cs + x1 * sn], axis=-2)
    return out.reshape(b, s, h, dh).astype(x.dtype)


def neighbourhood_attention(q, k, v, k_ctx, v_ctx, rpb):
    b, s, h, dh = q.shape
    rows = s // GRID_W
    kr = min(WIN_ROWS, rows)
    n_cb = GRID_W // Q_COL_BLOCK
    scale = dh ** -0.5
    qg = q.reshape(b, rows, n_cb, Q_COL_BLOCK, h, dh)
    kg = k.reshape(b, rows, GRID_W, h, dh)
    vg = v.reshape(b, rows, GRID_W, h, dh)
    cb = jnp.arange(n_cb)
    q_cols = cb[:, None] * Q_COL_BLOCK + jnp.arange(Q_COL_BLOCK)[None, :]
    q_col0 = jnp.clip(q_cols - WIN_COLS // 2, 0, GRID_W - WIN_COLS)
    k_col0 = jnp.clip(cb * Q_COL_BLOCK - WIN_COLS // 2, 0, GRID_W - K_COL_BLOCK)
    k_cols = k_col0[:, None] + jnp.arange(K_COL_BLOCK)[None, :]
    kc = k_cols[:, None, :]
    col_valid = (kc >= q_col0[..., None]) & (kc < q_col0[..., None] + WIN_COLS)
    col_idx = jnp.clip(kc - q_cols[..., None] + WIN_COLS - 1, 0, 2 * WIN_COLS - 2)
    mask = col_valid[:, :, None, :]
    n_win = kr * K_COL_BLOCK

    def row_block(r):
        r0 = jnp.clip(r - kr // 2, 0, rows - kr)
        q_r = lax.dynamic_index_in_dim(qg, r, axis=1, keepdims=False)
        k_band = lax.dynamic_slice_in_dim(kg, r0, kr, axis=1)[:, :, k_cols]
        v_band = lax.dynamic_slice_in_dim(vg, r0, kr, axis=1)[:, :, k_cols]
        row_idx = r0 + jnp.arange(kr) - r + WIN_ROWS - 1
        bias = rpb[:, row_idx[None, None, :, None], col_idx[:, :, None, :]]
        s_win = jnp.einsum('bnqhd,brnkhd->bhnqrk', q_r, k_band,
                           preferred_element_type=jnp.float32) * scale
        s_win = jnp.where(mask, s_win + bias.astype(jnp.float32), NEG_INF)
        s_ctx = jnp.einsum('bnqhd,blhd->bhnql', q_r, k_ctx,
                           preferred_element_type=jnp.float32) * scale
        scores = jnp.concatenate([s_win.reshape(b, h, n_cb, Q_COL_BLOCK, n_win), s_ctx], axis=-1)
        p = jax.nn.softmax(scores, axis=-1).astype(v.dtype)
        p_win = p[..., :n_win].reshape(b, h, n_cb, Q_COL_BLOCK, kr, K_COL_BLOCK)
        out = (jnp.einsum('bhnqrk,brnkhd->bnqhd', p_win, v_band)
               + jnp.einsum('bhnql,blhd->bnqhd', p[..., n_win:], v_ctx))
        return out.reshape(b, GRID_W, h * dh)

    out = lax.map(row_block, jnp.arange(rows))
    return jnp.moveaxis(out, 0, 1).reshape(b, s, h * dh)


def context_attention(q, k, v):
    b, l, h, dh = q.shape
    scores = jnp.einsum('blhd,bmhd->bhlm', q, k, preferred_element_type=jnp.float32) * dh ** -0.5
    p = jax.nn.softmax(scores, axis=-1).astype(v.dtype)
    return jnp.einsum('bhlm,bmhd->blhd', p, v).reshape(b, l, h * dh)


def multiscale_pool(p, pool_w, pool_scale):
    b, n, _ = p.shape
    pf = p.astype(jnp.float32).reshape(b, n, N_POOL_GROUPS, POOL_GROUP)
    csum = jnp.concatenate([jnp.zeros_like(pf[:, :1]), jnp.cumsum(pf, axis=1)], axis=1)
    t = jnp.arange(n)
    groups = []
    for g, w in enumerate(POOL_WINDOWS):
        lo = jnp.clip(t - w // 2, 0, n)
        hi = jnp.clip(t + w - w // 2, 0, n)
        cnt = (hi - lo).astype(jnp.float32)[None, :, None]
        mean = (csum[:, hi, g] - csum[:, lo, g]) / cnt
        groups.append(mean - pf[:, :, g])
    pooled = jnp.stack(groups, axis=2).astype(p.dtype)
    mixed = jnp.einsum('bngc,gcd->bngd', pooled, pool_w)
    return mixed.reshape(b, n, POOL_WIDTH) * pool_scale


def merge_branches(attn, pool, gates, b_gate, w_proj_a, w_proj_b, w_out):
    g = jax.nn.sigmoid(gates + b_gate)
    g_a, g_b = jnp.split(g, 2, axis=-1)
    return (g_a * (attn @ w_proj_a) + g_b * (pool @ w_proj_b)) @ w_out


def swiglu(h, w_up, w_down):
    gate, up = jnp.split(h @ w_up, 2, axis=-1)
    return (jax.nn.silu(gate) * up) @ w_down


def setup_inputs(seed: int = 0) -> dict:
    key = jax.random.key(seed)
    ks = jax.random.split(key, 20)

    def nrm(k, shape, s):
        return jax.random.normal(k, shape, jnp.float32) * s

    return {
        'x': nrm(ks[0], (BATCH, SEQ, D_MODEL), 1.0),
        'c': nrm(ks[1], (BATCH, D_MODEL), 1.0),
        'ctx': nrm(ks[2], (BATCH, CTX_LEN, D_MODEL), 1.0),
        'c_ctx': nrm(ks[3], (D_MODEL,), 1.0),
        'w_ada': nrm(ks[4], (DEPTH, D_MODEL, N_MOD * D_MODEL), 0.5 * D_MODEL ** -0.5),
        'b_ada': nrm(ks[5], (DEPTH, N_MOD * D_MODEL), 0.02),
        'g_pre_mix': 1.0 + nrm(ks[6], (DEPTH, D_MODEL), 0.05),
        'g_post_mix': 1.0 + nrm(ks[7], (DEPTH, D_MODEL), 0.05),
        'g_pre_ffn': 1.0 + nrm(ks[8], (DEPTH, D_MODEL), 0.05),
        'g_post_ffn': 1.0 + nrm(ks[9], (DEPTH, D_MODEL), 0.05),
        'w_in': nrm(ks[10], (DEPTH, D_MODEL, IN_COLS), D_MODEL ** -0.5),
        'b_gate': nrm(ks[11], (DEPTH, GATE_WIDTH), 0.02),
        'rpb': nrm(ks[12], (DEPTH, N_HEADS, 2 * WIN_ROWS - 1, 2 * WIN_COLS - 1), 0.02),
        'pool_w': nrm(ks[13], (DEPTH, N_POOL_GROUPS, POOL_GROUP, POOL_GROUP), POOL_GROUP ** -0.5),
        'pool_scale': 1.0 + nrm(ks[14], (DEPTH, POOL_WIDTH), 0.1),
        'w_proj_a': nrm(ks[15], (DEPTH, ATTN_WIDTH, D_MODEL), ATTN_WIDTH ** -0.5),
        'w_proj_b': nrm(ks[16], (DEPTH, POOL_WIDTH, D_MODEL), POOL_WIDTH ** -0.5),
        'w_out': nrm(ks[17], (DEPTH, D_MODEL, D_MODEL), D_MODEL ** -0.5),
        'w_up': nrm(ks[18], (DEPTH, D_MODEL, 2 * D_FF), D_MODEL ** -0.5),
        'w_down': nrm(ks[19], (DEPTH, D_FF, D_MODEL), D_FF ** -0.5),
    }


def reference(x, c, ctx, c_ctx, w_ada, b_ada, g_pre_mix, g_post_mix, g_pre_ffn, g_post_ffn,
              w_in, b_gate, rpb, pool_w, pool_scale, w_proj_a, w_proj_b, w_out, w_up, w_down):
    cos, sin = axial_rope_tables(x.shape[1])
    for layer in range(DEPTH):
        update_ctx = layer < DEPTH - 1
        mod = jax.nn.silu(c) @ w_ada[layer] + b_ada[layer]
        sh1, sc1, gt1, sh2, sc2, gt2 = jnp.split(mod[:, None, :], N_MOD, axis=-1)
        n_ctx_mod = N_MOD if update_ctx else 2
        mod_ctx = (jax.nn.silu(c_ctx) @ w_ada[layer][:, :n_ctx_mod * D_MODEL]
                   + b_ada[layer][:n_ctx_mod * D_MODEL])
        mod_ctx = jnp.split(mod_ctx, n_ctx_mod)

        h = modulate(rms_norm(x, g_pre_mix[layer]), sh1, sc1)
        h_ctx = modulate(rms_norm(ctx, g_pre_mix[layer]), mod_ctx[0], mod_ctx[1])
        q, k, v, p, gates = split_projection(h @ w_in[layer])
        if update_ctx:
            q_c, k_c, v_c, p_c, gates_c = split_projection(h_ctx @ w_in[layer])
        else:
            k_c, v_c = jnp.split(h_ctx @ w_in[layer][:, ATTN_WIDTH:3 * ATTN_WIDTH], 2, axis=-1)
        k_c, v_c = heads(k_c), heads(v_c)
        q = apply_rope(heads(q), cos, sin)
        k = apply_rope(heads(k), cos, sin)
        attn = neighbourhood_attention(q, k, heads(v), k_c, v_c, rpb[layer])
        pool = multiscale_pool(p, pool_w[layer], pool_scale[layer])
        y = merge_branches(attn, pool, gates, b_gate[layer], w_proj_a[layer], w_proj_b[layer], w_out[layer])
        x = x + gt1 * rms_norm(y, g_post_mix[layer])
        if update_ctx:
            attn_c = context_attention(heads(q_c), k_c, v_c)
            pool_c = multiscale_pool(p_c, pool_w[layer], pool_scale[layer])
            y_c = merge_branches(attn_c, pool_c, gates_c, b_gate[layer], w_proj_a[layer],
                                 w_proj_b[layer], w_out[layer])
            ctx = ctx + mod_ctx[2] * rms_norm(y_c, g_post_mix[layer])

        h = modulate(rms_norm(x, g_pre_ffn[layer]), sh2, sc2)
        x = x + gt2 * rms_norm(swiglu(h, w_up[layer], w_down[layer]), g_post_ffn[layer])
        if update_ctx:
            h_c = modulate(rms_norm(ctx, g_pre_ffn[layer]), mod_ctx[3], mod_ctx[4])
            ctx = ctx + mod_ctx[5] * rms_norm(swiglu(h_c, w_up[layer], w_down[layer]), g_post_ffn[layer])
    return x
```

```cpp
#include <hip/hip_runtime.h>
#include <cstdio>
#include <cstdint>
namespace pg8 {
#define PG8_LAS __attribute__((address_space(3)))
typedef unsigned short bf16_t;
typedef short bf16x8 __attribute__((ext_vector_type(8)));
typedef float f32x4 __attribute__((ext_vector_type(4)));
typedef unsigned u32x4 __attribute__((ext_vector_type(4)));
constexpr int BM = 256, BK = 64, HALF = 128, HTB = HALF * BK * 2  , STAGE_BYTES = 8 * HTB, NXCD = 8, WGM = 8;

__host__ __device__ __forceinline__ int lds_byte(int r, int c) { const int st = (r >> 4) * 2 + (c >> 5), rr = r & 15, cc = c & 31, ob = rr * 64 + cc * 2; return st * 1024 + (ob ^ (((ob >> 9) & 1) << 5)); }
__host__ __device__ __forceinline__ void stage_rc(int b, int& R, int& C) { const int st = b / 1024, sb = b % 1024, swz = sb ^ (((sb >> 9) & 1) << 5); R = (st >> 1) * 16 + swz / 64; C = (st & 1) * 32 + (swz % 64) / 2; }
__host__ __device__ __forceinline__ int perm32(int rho) { const int n = rho >> 4, i = rho & 15; return 8 * (i >> 2) + 4 * n + (i & 3); }

struct Unit { int pm, pn, sel; };
struct Gemm { const bf16_t* A; const bf16_t* Bt; const bf16_t* A1; const bf16_t* Bt1; int M, N, K; };

struct StaticOrder {
    int nM, nN, nwg, G, c;
    __host__ __device__ void init(int M, int N, int G_, int c_) { nM = M / BM; nN = N / BM; nwg = nM * nN; G = G_; c = c_; }
    __host__ __device__ bool next(int i, Unit& u) const {
        const long L = (long)i * G + c; if (L >= nwg) return false;
        int wgid = (int)L; { const int q = nwg / NXCD, r = nwg % NXCD, xcd = wgid % NXCD, off = wgid / NXCD; wgid = (xcd < r ? xcd * (q + 1) : r * (q + 1) + (xcd - r) * q) + off; }
        const int nig = WGM * nN, gid = wgid / nig, fm = gid * WGM, gsz = (nM - fm) < WGM ? (nM - fm) : WGM;
        u.pm = fm + ((wgid % nig) % gsz); u.pn = (wgid % nig) / gsz; u.sel = 0; return true;
    }
    __device__ __forceinline__ void a_ready(const Unit&) const {}
    __device__ __forceinline__ void done(const Unit&) const {}
};

typedef __bf16 bf16x2_t __attribute__((ext_vector_type(2)));
typedef float f32x2_t __attribute__((ext_vector_type(2)));
__device__ __forceinline__ unsigned cvt_pk_bf16(float lo, float hi) { const f32x2_t v = {lo, hi}; return __builtin_bit_cast(unsigned, __builtin_convertvector(v, bf16x2_t)); }

typedef unsigned u32x2 __attribute__((ext_vector_type(2)));
constexpr float LOG2E = 1.4426950408889634f;
constexpr float QSCALE = 0.125f * LOG2E;
__device__ __forceinline__ u32x4 pack8(const f32x4 a, const f32x4 b) { u32x4 w; w.x = cvt_pk_bf16(a[0], a[1]); w.y = cvt_pk_bf16(a[2], a[3]); w.z = cvt_pk_bf16(b[0], b[1]); w.w = cvt_pk_bf16(b[2], b[3]); return w; }
__device__ __forceinline__ void unpack8(const u32x4 w, f32x4& a, f32x4& b) {
    a[0] = __uint_as_float(w.x << 16); a[1] = __uint_as_float(w.x & 0xffff0000u); a[2] = __uint_as_float(w.y << 16); a[3] = __uint_as_float(w.y & 0xffff0000u);
    b[0] = __uint_as_float(w.z << 16); b[1] = __uint_as_float(w.z & 0xffff0000u); b[2] = __uint_as_float(w.w << 16); b[3] = __uint_as_float(w.w & 0xffff0000u); }
__device__ __forceinline__ float sigmoid_f(float v) { return __builtin_amdgcn_rcpf(1.0f + __builtin_amdgcn_exp2f(-v * LOG2E)); }
__device__ __forceinline__ f32x4 sigmoid4(const f32x4 v) { f32x4 r; r[0] = sigmoid_f(v[0]); r[1] = sigmoid_f(v[1]); r[2] = sigmoid_f(v[2]); r[3] = sigmoid_f(v[3]); return r; }

struct EpiPlain {
    static constexpr bool PERM = true, AFTER_DRAIN = false;
    bf16_t* O; int ldc;
    __device__ __forceinline__ void operator()(const f32x4 (&acc)[2][2][4][2], const Unit& u, int wr, int wc, int fr, int fq) const {
        const int row0 = u.pm * BM + wr * 64 + fr, col0 = u.pn * BM + wc * 32 + 8 * fq;
#pragma unroll
        for (int ai = 0; ai < 2; ++ai)
#pragma unroll
            for (int m = 0; m < 4; ++m) { bf16_t* rowp = O + (size_t)(row0 + ai * HALF + m * 16) * ldc + col0;
#pragma unroll
                for (int bj = 0; bj < 2; ++bj) *(u32x4*)(rowp + bj * HALF) = pack8(acc[ai][bj][m][0], acc[ai][bj][m][1]); }
    }
};
struct EpiProj {
    static constexpr bool PERM = true, AFTER_DRAIN = false;
    bf16_t *Q, *K, *P, *G; const float* rope; const float* bgate;
    __device__ __forceinline__ void operator()(const f32x4 (&acc)[2][2][4][2], const Unit& u, int wr, int wc, int fr, int fq) const {
        const int pn = u.pn, row0 = u.pm * BM + wr * 64 + fr;
        if (pn < 4) {
            bf16_t* dst = pn < 2 ? Q : K; const float qs = pn < 2 ? QSCALE : 1.0f; const int hb = (pn & 1) * 4 + (wc >> 1), half = wc & 1;
#pragma unroll
            for (int ai = 0; ai < 2; ++ai)
#pragma unroll
                for (int m = 0; m < 4; ++m) {
                    const int row = row0 + ai * HALF + m * 16, b = row >> 13, t = row & 8191, pos = half ? (t & 63) : (t >> 6);
                    const f32x4 cs = *(const f32x4*)(rope + pos * 32 + 4 * fq) * qs, sn = *(const f32x4*)(rope + pos * 32 + 16 + 4 * fq) * qs;
#pragma unroll
                    for (int bj = 0; bj < 2; ++bj) {
                        const int h = hb + 2 * bj; const f32x4 x1 = acc[ai][bj][m][0], x2 = acc[ai][bj][m][1];
                        const f32x4 o1 = x1 * cs - x2 * sn, o2 = x2 * cs + x1 * sn;
                        *(u32x4*)(dst + ((size_t)((b * 8 + h) * 8192 + t)) * 64 + 32 * half + 8 * fq) = pack8(o1, o2);
                    }
                }
        } else if (pn < 6) {
            const int col0 = (pn - 4) * BM + wc * 32 + 8 * fq;
#pragma unroll
            for (int ai = 0; ai < 2; ++ai)
#pragma unroll
                for (int m = 0; m < 4; ++m) { bf16_t* rowp = P + (size_t)(row0 + ai * HALF + m * 16) * 512 + col0;
#pragma unroll
                    for (int bj = 0; bj < 2; ++bj) *(u32x4*)(rowp + bj * HALF) = pack8(acc[ai][bj][m][0], acc[ai][bj][m][1]); }
        } else {
            const int col0 = (pn - 6) * BM + wc * 32 + 8 * fq;
            f32x4 bv[2][2];
#pragma unroll
            for (int bj = 0; bj < 2; ++bj)
#pragma unroll
                for (int n = 0; n < 2; ++n) bv[bj][n] = *(const f32x4*)(bgate + col0 + bj * HALF + 4 * n);
#pragma unroll
            for (int ai = 0; ai < 2; ++ai)
#pragma unroll
                for (int m = 0; m < 4; ++m) { bf16_t* rowp = G + (size_t)(row0 + ai * HALF + m * 16) * 2048 + col0;
#pragma unroll
                    for (int bj = 0; bj < 2; ++bj) *(u32x4*)(rowp + bj * HALF) = pack8(sigmoid4(acc[ai][bj][m][0] + bv[bj][0]), sigmoid4(acc[ai][bj][m][1] + bv[bj][1])); }
        }
    }
};
struct EpiVT {
    static constexpr bool PERM = true, AFTER_DRAIN = false;
    bf16_t* VT;
    __device__ __forceinline__ void operator()(const f32x4 (&acc)[2][2][4][2], const Unit& u, int wr, int wc, int fr, int fq) const {
        const int row0 = u.pm * BM + wr * 64 + fr, col0 = u.pn * BM + wc * 32 + 8 * fq;
#pragma unroll
        for (int ai = 0; ai < 2; ++ai)
#pragma unroll
            for (int m = 0; m < 4; ++m) { const int ch = row0 + ai * HALF + m * 16;
#pragma unroll
                for (int bj = 0; bj < 2; ++bj) { const int tok = col0 + bj * HALF, b = tok >> 13, t = tok & 8191;
                    *(u32x4*)(VT + ((size_t)(b * 512 + ch)) * 8192 + t) = pack8(acc[ai][bj][m][0], acc[ai][bj][m][1]); } }
    }
};
struct EpiMerge {
    static constexpr bool PERM = true, AFTER_DRAIN = false;
    const bf16_t* G; bf16_t* O;
    __device__ __forceinline__ void operator()(const f32x4 (&acc)[2][2][4][2], const Unit& u, int wr, int wc, int fr, int fq) const {
        const int row0 = u.pm * BM + wr * 64 + fr, col0 = u.pn * BM + wc * 32 + 8 * fq, sel = u.sel;
#pragma unroll
        for (int ai = 0; ai < 2; ++ai)
#pragma unroll
            for (int m = 0; m < 4; ++m) { const size_t row = (size_t)(row0 + ai * HALF + m * 16);
#pragma unroll
                for (int bj = 0; bj < 2; ++bj) {
                    f32x4 g0, g1; unpack8(*(const u32x4*)(G + row * 2048 + sel * 1024 + col0 + bj * HALF), g0, g1);
                    f32x4 v0 = acc[ai][bj][m][0] * g0, v1 = acc[ai][bj][m][1] * g1;
                    bf16_t* op = O + row * 1024 + col0 + bj * HALF;
                    if (sel) { f32x4 p0, p1; unpack8(*(const u32x4*)op, p0, p1); v0 += p0; v1 += p1; }
                    *(u32x4*)op = pack8(v0, v1);
                } }
    }
};
struct EpiSwiglu {
    static constexpr bool PERM = true, AFTER_DRAIN = false;
    bf16_t* ACT;
    __device__ __forceinline__ void operator()(const f32x4 (&acc)[2][2][4][2], const Unit& u, int wr, int wc, int fr, int fq) const {
        const int row0 = u.pm * BM + wr * 64 + fr, col0 = u.pn * HALF + wc * 32 + 8 * fq;
#pragma unroll
        for (int ai = 0; ai < 2; ++ai)
#pragma unroll
            for (int m = 0; m < 4; ++m) {
                const f32x4 g0 = acc[ai][0][m][0], g1 = acc[ai][0][m][1];
                const f32x4 v0 = g0 * sigmoid4(g0) * acc[ai][1][m][0], v1 = g1 * sigmoid4(g1) * acc[ai][1][m][1];
                *(u32x4*)(ACT + (size_t)(row0 + ai * HALF + m * 16) * 2816 + col0) = pack8(v0, v1); }
    }
};
struct PairOrder {
    StaticOrder S;
    __host__ __device__ bool next(int i, Unit& u) const { if (!S.next(i >> 1, u)) return false; u.sel = i & 1; return true; }
    __device__ __forceinline__ void a_ready(const Unit&) const {}
    __device__ __forceinline__ void done(const Unit&) const {}
};


#ifndef DBG_ZERO_ALL
#define DBG_ZERO_ALL 0
#endif
#ifndef DBG_NAIVE_GEMM
#define DBG_NAIVE_GEMM 0
#endif
template <class Epi, class Sched>
__device__ __forceinline__ void gemm_phase_naive(const Gemm g, const Sched& S, const Epi& E) {
    static_assert(Epi::PERM, "naive body written for PERM epilogues");
    const int tid = threadIdx.x, wid = __builtin_amdgcn_readfirstlane(tid >> 6), lane = tid & 63, wr = wid >> 2, wc = wid & 3, fr = lane & 15, fq = lane >> 4;
    Unit cur;
    for (int ui = 0; S.next(ui, cur); ++ui) {
        const bf16_t* A = cur.sel ? g.A1 : g.A; const bf16_t* Bt = cur.sel ? g.Bt1 : g.Bt;
        f32x4 acc[2][2][4][2];
#pragma unroll
        for (int a = 0; a < 2; ++a)
#pragma unroll
            for (int b = 0; b < 2; ++b)
#pragma unroll
                for (int m = 0; m < 4; ++m)
#pragma unroll
                    for (int n = 0; n < 2; ++n) acc[a][b][m][n] = (f32x4){0.f, 0.f, 0.f, 0.f};
        const bf16_t* ar = A + (size_t)(cur.pm * BM + wr * 64 + fr) * g.K; const bf16_t* br = Bt + (size_t)(cur.pn * BM + wc * 32 + 8 * fq) * g.K;
#pragma unroll
        for (int bj = 0; bj < 2; ++bj)
#pragma unroll
            for (int n = 0; n < 2; ++n)
                for (int k = 0; k < g.K; k += 8) {
                    f32x4 bl[4], bh[4];
#pragma unroll
                    for (int e = 0; e < 4; ++e) unpack8(*(const u32x4*)(br + (size_t)(bj * HALF + 4 * n + e) * g.K + k), bl[e], bh[e]);
#pragma unroll
                    for (int ai = 0; ai < 2; ++ai)
#pragma unroll
                        for (int m = 0; m < 4; ++m) { f32x4 al, ah; unpack8(*(const u32x4*)(ar + (size_t)(ai * HALF + m * 16) * g.K + k), al, ah);
#pragma unroll
                            for (int e = 0; e < 4; ++e) { const f32x4 p = al * bl[e] + ah * bh[e]; acc[ai][bj][m][n][e] += (p[0] + p[1]) + (p[2] + p[3]); } }
                }
        E(acc, cur, wr, wc, fr, fq);
    }
    __syncthreads();
}
template <class Epi, class Sched, bool ALIGN_EPI = false, bool SP2 = false>
__device__ __forceinline__ void gemm_phase(PG8_LAS unsigned char* lds, const Gemm g, const Sched& S, const Epi& E) {
    const int tid = threadIdx.x, wid = __builtin_amdgcn_readfirstlane(tid >> 6), lane = tid & 63, wr = wid >> 2, wc = wid & 3, fr = lane & 15, fq = lane >> 4;
    const int K = g.K, nt = K / BK;
    unsigned voffA[2], voffB[2];
#pragma unroll
    for (int i = 0; i < 2; ++i) { int R, C; stage_rc(tid * 16 + i * 8192, R, C); const int Rb = Epi::PERM ? ((R & ~31) + perm32(R & 31)) : R;
        voffA[i] = (unsigned)(R * K + C) * 2u; voffB[i] = (unsigned)(Rb * K + C) * 2u; }
    const size_t kstep = (size_t)(BK * 2);
    const size_t hstep = (size_t)HALF * K * 2;
    const size_t tstep = 2 * hstep;
    const unsigned ldsw = (unsigned)wid * 1024u;
    const int aoff = lds_byte(wr * 64 + fr, fq * 8), boff = lds_byte(wc * 32 + fr, fq * 8);
#define PG8_SA(b, h) (((b) * 2 + (h)) * HTB)
#define PG8_SB(b, h) ((4 + (b) * 2 + (h)) * HTB)
#define PG8_STAGE(bufoff, gbase, voff) do { _Pragma("unroll") for (int _i = 0; _i < 2; ++_i) \
        __builtin_amdgcn_global_load_lds((const unsigned*)((const char*)(gbase) + (voff)[_i]), (PG8_LAS unsigned*)(lds + (bufoff) + ldsw + _i * 8192), 16, 0, 0); } while (0)
#define PG8_LDA(dst, b, h) do { _Pragma("unroll") for (int m = 0; m < 4; ++m) _Pragma("unroll") for (int k = 0; k < 2; ++k) dst[m][k] = *(const PG8_LAS bf16x8*)(lds + PG8_SA(b, h) + aoff + m * 2048 + k * 1024); } while (0)
#define PG8_LDB(dst, b, h) do { _Pragma("unroll") for (int n = 0; n < 2; ++n) _Pragma("unroll") for (int k = 0; k < 2; ++k) dst[n][k] = *(const PG8_LAS bf16x8*)(lds + PG8_SB(b, h) + boff + n * 2048 + k * 1024); } while (0)
#define PG8_MMA(ai, bj, At, Bt) do { __builtin_amdgcn_s_setprio(1); _Pragma("unroll") for (int m = 0; m < 4; ++m) _Pragma("unroll") for (int n = 0; n < 2; ++n) _Pragma("unroll") for (int k = 0; k < 2; ++k) \
        acc[ai][bj][m][n] = __builtin_amdgcn_mfma_f32_16x16x32_bf16(Bt[n][k], At[m][k], acc[ai][bj][m][n], 0, 0, 0); __builtin_amdgcn_s_setprio(0); } while (0)
#define PG8_WAIT_V(n) asm volatile("s_waitcnt vmcnt(" #n ")" ::: "memory")
#define PG8_WAIT_L(n) asm volatile("s_waitcnt lgkmcnt(" #n ")" ::: "memory")
#define PG8_BAR __builtin_amdgcn_s_barrier()
#define PG8_SCHED __builtin_amdgcn_sched_barrier(0)
    Unit cur, nxt; int ui = 0;
    if (!S.next(0, cur)) return;
    f32x4 acc[2][2][4][2];
#pragma unroll
    for (int a = 0; a < 2; ++a)
#pragma unroll
        for (int b = 0; b < 2; ++b)
#pragma unroll
            for (int m = 0; m < 4; ++m)
#pragma unroll
                for (int n = 0; n < 2; ++n) acc[a][b][m][n] = (f32x4){0.f, 0.f, 0.f, 0.f};
    bf16x8 At[4][2], B0[2][2], B1[2][2];
    const char* cA = (const char*)(cur.sel ? g.A1 : g.A) + (size_t)cur.pm * tstep; const char* cB = (const char*)(cur.sel ? g.Bt1 : g.Bt) + (size_t)cur.pn * tstep;
    S.a_ready(cur);
    if constexpr (SP2) {
        PG8_STAGE(PG8_SB(0, 0), cB, voffB); PG8_STAGE(PG8_SB(0, 1), cB + hstep, voffB); PG8_STAGE(PG8_SA(0, 0), cA, voffA); PG8_STAGE(PG8_SA(0, 1), cA + hstep, voffA);
        if (wr == 1) PG8_BAR;
        PG8_WAIT_V(2); PG8_BAR;
        PG8_STAGE(PG8_SB(1, 0), cB + kstep, voffB); PG8_STAGE(PG8_SA(1, 0), cA + kstep, voffA); PG8_STAGE(PG8_SB(1, 1), cB + hstep + kstep, voffB);
        PG8_WAIT_V(6); PG8_BAR;
    } else {
        PG8_STAGE(PG8_SB(0, 0), cB, voffB); PG8_STAGE(PG8_SA(0, 0), cA, voffA); PG8_STAGE(PG8_SB(0, 1), cB + hstep, voffB); PG8_STAGE(PG8_SA(0, 1), cA + hstep, voffA);
        if (wr == 1) PG8_BAR;
        PG8_WAIT_V(4); PG8_BAR;
        PG8_STAGE(PG8_SB(1, 0), cB + kstep, voffB); PG8_STAGE(PG8_SA(1, 0), cA + kstep, voffA); PG8_STAGE(PG8_SB(1, 1), cB + hstep + kstep, voffB);
        PG8_WAIT_V(6); PG8_BAR;
    }
    for (;;) {
        const bool has_next = S.next(ui + 1, nxt);
        const char* nA = has_next ? (const char*)(nxt.sel ? g.A1 : g.A) + (size_t)nxt.pm * tstep : cA; const char* nB = has_next ? (const char*)(nxt.sel ? g.Bt1 : g.Bt) + (size_t)nxt.pn * tstep : cB;
        for (int t = 0; t < nt; t += 2) {
            const bool last = (t == nt - 2);
            const char* a1 = cA + (size_t)(t + 1) * kstep;
            const char* a2 = last ? nA : cA + (size_t)(t + 2) * kstep; const char* b2 = last ? nB : cB + (size_t)(t + 2) * kstep;
            const char* a3 = a2 + kstep; const char* b3 = b2 + kstep;
            if (last && has_next) S.a_ready(nxt);
            if constexpr (SP2) {
            PG8_LDB(B0, 0, 0); PG8_LDB(B1, 0, 1); PG8_SCHED; PG8_LDA(At, 0, 0); PG8_STAGE(PG8_SA(1, 1), a1 + hstep, voffA);
            PG8_WAIT_V(8); PG8_WAIT_L(0); PG8_BAR; PG8_MMA(0, 0, At, B0); PG8_MMA(0, 1, At, B1); PG8_BAR; PG8_SCHED;
            PG8_LDA(At, 0, 1); PG8_STAGE(PG8_SB(0, 0), b2, voffB); PG8_STAGE(PG8_SB(0, 1), b2 + hstep, voffB); PG8_STAGE(PG8_SA(0, 0), a2, voffA);
            PG8_WAIT_V(8); PG8_WAIT_L(0); PG8_BAR; PG8_MMA(1, 0, At, B0); PG8_MMA(1, 1, At, B1); PG8_BAR; PG8_SCHED;
            PG8_LDB(B0, 1, 0); PG8_LDB(B1, 1, 1); PG8_SCHED; PG8_LDA(At, 1, 0); PG8_STAGE(PG8_SA(0, 1), a2 + hstep, voffA);
            PG8_WAIT_V(8); PG8_WAIT_L(0); PG8_BAR; PG8_MMA(0, 0, At, B0); PG8_MMA(0, 1, At, B1); PG8_BAR; PG8_SCHED;
            PG8_LDA(At, 1, 1); PG8_STAGE(PG8_SB(1, 0), b3, voffB); PG8_STAGE(PG8_SB(1, 1), b3 + hstep, voffB); PG8_STAGE(PG8_SA(1, 0), a3, voffA);
            PG8_WAIT_V(8); PG8_WAIT_L(0); PG8_BAR; PG8_MMA(1, 0, At, B0); PG8_MMA(1, 1, At, B1); PG8_BAR; PG8_SCHED;
            } else {
            PG8_LDB(B0, 0, 0); PG8_SCHED; PG8_LDA(At, 0, 0); PG8_STAGE(PG8_SA(1, 1), a1 + hstep, voffA);
            PG8_WAIT_L(8); PG8_BAR; PG8_WAIT_L(0); PG8_MMA(0, 0, At, B0); PG8_BAR; PG8_SCHED;
            PG8_LDB(B1, 0, 1); PG8_STAGE(PG8_SB(0, 0), b2, voffB);
            PG8_BAR; PG8_WAIT_L(0); PG8_MMA(0, 1, At, B1); PG8_BAR;
            PG8_LDA(At, 0, 1); PG8_STAGE(PG8_SA(0, 0), a2, voffA);
            PG8_BAR; PG8_WAIT_L(0); PG8_MMA(1, 0, At, B0); PG8_BAR; PG8_SCHED;
            PG8_STAGE(PG8_SB(0, 1), b2 + hstep, voffB);
            PG8_WAIT_V(6); PG8_BAR; PG8_MMA(1, 1, At, B1); PG8_BAR;
            PG8_LDB(B0, 1, 0); PG8_SCHED; PG8_LDA(At, 1, 0); PG8_STAGE(PG8_SA(0, 1), a2 + hstep, voffA);
            PG8_WAIT_L(8); PG8_BAR; PG8_WAIT_L(0); PG8_MMA(0, 0, At, B0); PG8_BAR; PG8_SCHED;
            PG8_LDB(B1, 1, 1); PG8_STAGE(PG8_SB(1, 0), b3, voffB);
            PG8_BAR; PG8_WAIT_L(0); PG8_MMA(0, 1, At, B1); PG8_BAR;
            PG8_LDA(At, 1, 1); PG8_STAGE(PG8_SA(1, 0), a3, voffA);
            PG8_BAR; PG8_WAIT_L(0); PG8_MMA(1, 0, At, B0); PG8_BAR; PG8_SCHED;
            PG8_STAGE(PG8_SB(1, 1), b3 + hstep, voffB);
            PG8_WAIT_V(6); PG8_BAR; PG8_MMA(1, 1, At, B1); PG8_BAR;
            }
        }
        if constexpr (ALIGN_EPI) { if (wr == 0) PG8_BAR; }
        if constexpr (!Epi::AFTER_DRAIN) { E(acc, cur, wr, wc, fr, fq); S.done(cur); }
        if (!has_next) break;
#pragma unroll
        for (int a = 0; a < 2; ++a)
#pragma unroll
            for (int b = 0; b < 2; ++b)
#pragma unroll
                for (int m = 0; m < 4; ++m)
#pragma unroll
                    for (int n = 0; n < 2; ++n) acc[a][b][m][n] = (f32x4){0.f, 0.f, 0.f, 0.f};
        cur = nxt; cA = nA; cB = nB; ++ui;
        if constexpr (ALIGN_EPI) { if (wr == 1) PG8_BAR; }
    }
    PG8_WAIT_V(0);
    if constexpr (!ALIGN_EPI) { if (wr == 0) PG8_BAR; }
    PG8_BAR;
    if constexpr (Epi::AFTER_DRAIN) { E.fused(acc, cur, wr, wc, fr, fq, lds, wid, lane); S.done(cur); }
#undef PG8_SA
#undef PG8_SB
#undef PG8_STAGE
#undef PG8_LDA
#undef PG8_LDB
#undef PG8_MMA
#undef PG8_WAIT_V
#undef PG8_WAIT_L
#undef PG8_BAR
#undef PG8_SCHED
}
}

constexpr int NWAVES = 8;
#ifndef MK_N_LAUNCHES
#define MK_N_LAUNCHES 1
#endif
constexpr int N_PHASES = 10;
constexpr int N_LAUNCHES = MK_N_LAUNCHES;
constexpr int NB = 4, SEQ = 8192, DM = 1024, M = NB * SEQ, CTXL = 256, NH = 8, HD = 64, AW = 512, PW = 512, GATEW = 2048, INC = 4096, FF = 2816, MODW = 6144;
constexpr int NIN1 = 3584;
constexpr float RMS_EPS = 1e-6f;
using pg8::bf16_t; using pg8::bf16x8; using pg8::f32x4; using pg8::u32x4; using pg8::u32x2; using pg8::LOG2E; using pg8::cvt_pk_bf16; using pg8::pack8; using pg8::unpack8;

constexpr size_t MiB = 1u << 20;
constexpr size_t WS_CTL = 0, CTL_ZERO_BYTES = 1 * MiB;
constexpr size_t WS_MOD = 1 * MiB;
constexpr size_t WS_ROPE = 1 * MiB + 512 * 1024;
constexpr size_t WS_WIN = 2 * MiB, WS_WV = 9 * MiB, WS_WA = 10 * MiB, WS_WB = 11 * MiB, WS_WOUT = 12 * MiB, WS_WUP = 14 * MiB, WS_WDOWN = 25 * MiB;
constexpr size_t WS_KC = 31 * MiB, WS_VCT = 32 * MiB;
constexpr size_t WS_H = 64 * MiB;
constexpr size_t WS_Q = 128 * MiB, WS_K = 160 * MiB, WS_VT = 192 * MiB, WS_P = 224 * MiB, WS_GATES = 256 * MiB;
constexpr size_t WS_ATTN = 384 * MiB, WS_POOLED = 416 * MiB, WS_MERGED = 448 * MiB;
constexpr size_t WS_Y = 128 * MiB;
constexpr size_t WS_ACT = 128 * MiB;
constexpr size_t WS_Z = 384 * MiB;
constexpr size_t WS_END = 512 * MiB;
static_assert(WS_WDOWN + (size_t)DM * FF * 2 <= WS_KC && WS_ACT + (size_t)M * FF * 2 <= WS_Z && WS_MERGED + (size_t)M * DM * 2 <= WS_END, "d_ws map");
constexpr int CW_BAR = 4096;

constexpr int RING_BYTES = 131072;
constexpr int LDSCTL_OFF = 135168, MISC_OFF = LDSCTL_OFF + 320;
constexpr int LDS_BYTES = 147456;
static_assert(MISC_OFF + 128 <= LDS_BYTES, "LDS map");
constexpr int CTXROW_B = 2064;
static_assert(64 * CTXROW_B <= LDSCTL_OFF, "LDS map");

#define LAS __attribute__((address_space(3)))
#define LDS_WAIT() asm volatile("s_waitcnt lgkmcnt(0)" ::: "memory")
#define VM_WAIT() asm volatile("s_waitcnt vmcnt(0)" ::: "memory")
__device__ __forceinline__ unsigned f2bf(float f) { unsigned u = __builtin_bit_cast(unsigned, f); return (u + 0x7fffu + ((u >> 16) & 1u)) >> 16; }
__device__ __forceinline__ unsigned pk2(float lo, float hi) { return f2bf(lo) | (f2bf(hi) << 16); }
__device__ __forceinline__ float wave_sum(float v) {
#pragma unroll
    for (int o = 1; o < 64; o <<= 1) v += __shfl_xor(v, o);
    return v;
}
#define XB_TMO      128
#define XB_XCNT(j)  (256  + 64 * (j))
#define XB_XSUB(j)  (1280 + 64 * (j))
#define XB_XGEN(j)  (2304 + 64 * (j))
#define XB_TOP      3328
#define XB_TOPGEN   3392
#define XCD_BAR_WORDS 3456
#define XB_SPIN_CAP (1u << 18)

__device__ __forceinline__ unsigned xb_ld(unsigned* p)              { return __hip_atomic_load(p, __ATOMIC_RELAXED, __HIP_MEMORY_SCOPE_AGENT); }
__device__ __forceinline__ unsigned xb_add(unsigned* p, unsigned v) { return __hip_atomic_fetch_add(p, v, __ATOMIC_RELAXED, __HIP_MEMORY_SCOPE_AGENT); }
__device__ __forceinline__ unsigned xb_xcc_id() { return (unsigned)__builtin_amdgcn_s_getreg((3 << 11) | 20) & 0xFu; }
#define XB_SPIN(cond, bar) do { unsigned _sp = 0; while (cond) { __builtin_amdgcn_s_sleep(1); \
    if ((++_sp & 255u) == 0u) { if (xb_ld(&(bar)[XB_TMO])) break; if (_sp > XB_SPIN_CAP) { atomicAdd(&(bar)[XB_TMO], 1u); break; } } } } while (0)

struct XcdBarrier {
    unsigned* bar; unsigned x;
    volatile LAS unsigned* st;
};

__device__ __forceinline__ XcdBarrier xcd_barrier_post(unsigned* bar, volatile LAS unsigned* st) {
    XcdBarrier b; b.bar = bar; b.x = xb_xcc_id(); b.st = st;
    if (threadIdx.x == 0) (void)xb_add(&bar[XB_XCNT(b.x)], 1u);
    return b;
}
__device__ __forceinline__ void xcd_barrier_complete(unsigned* bar, unsigned x, unsigned& nloc, unsigned& nx) {
    const unsigned G = gridDim.x * gridDim.y * gridDim.z;
    unsigned sum, cnt, mine, sp = 0u;
    for (;;) {
        sum = 0u; cnt = 0u; mine = 0u;
#pragma unroll
        for (unsigned j = 0; j < 16; ++j) { const unsigned c = xb_ld(&bar[XB_XCNT(j)]); sum += c; cnt += (c > 0u) ? 1u : 0u; mine = (j == x) ? c : mine; }
        if (sum == G) break;
        __builtin_amdgcn_s_sleep(1);
        if ((++sp & 255u) == 0u) { if (xb_ld(&bar[XB_TMO])) break; if (sp > XB_SPIN_CAP) { atomicAdd(&bar[XB_TMO], 1u); break; } }
    }
    nloc = mine > 0u ? mine : 1u; nx = cnt > 0u ? cnt : 1u;
}

__device__ __forceinline__ void xcd_barrier(const XcdBarrier& b) {
    asm volatile("s_waitcnt vmcnt(0)" ::: "memory");
    __syncthreads();
    if (threadIdx.x == 0) {
        unsigned* bar = b.bar;
        __builtin_amdgcn_s_waitcnt(0);
        unsigned nloc = b.st[0], nx = b.st[1];
        if (nloc == 0u) { xcd_barrier_complete(bar, b.x, nloc, nx); b.st[0] = nloc; b.st[1] = nx; }
        const unsigned old = xb_add(&bar[XB_XSUB(b.x)], 1u);
        const unsigned gen = old / nloc;
        if (old + 1u == (gen + 1u) * nloc) {
            __builtin_amdgcn_fence(__ATOMIC_RELEASE, "agent");
            asm volatile("s_waitcnt vmcnt(0)" ::: "memory");
            const unsigned og = xb_add(&bar[XB_TOP], 1u);
            const unsigned tg = og / nx;
            if (og + 1u == (tg + 1u) * nx) xb_add(&bar[XB_TOPGEN], 1u);
            else XB_SPIN(xb_ld(&bar[XB_TOPGEN]) == tg, bar);
            __builtin_amdgcn_fence(__ATOMIC_ACQUIRE, "agent");
            xb_add(&bar[XB_XGEN(b.x)], 1u);
            asm volatile("s_waitcnt vmcnt(0)" ::: "memory");
        } else {
            XB_SPIN(xb_ld(&bar[XB_XGEN(b.x)]) == gen, bar);
            __builtin_amdgcn_fence(__ATOMIC_ACQUIRE, "agent");
            asm volatile("s_waitcnt vmcnt(0)" ::: "memory");
        }
    }
    __syncthreads();
}

struct Frame {
    LAS unsigned char* lds;
    volatile LAS unsigned* MISC;
    unsigned* ctl;
    int tid, lane, wave, vcu, G;
    const float *x, *c, *ctx, *c_ctx, *w_ada, *b_ada, *g_pre_mix, *g_post_mix, *g_pre_ffn, *g_post_ffn, *w_in, *b_gate, *rpb, *pool_w, *pool_scale, *w_proj_a, *w_proj_b, *w_out, *w_up, *w_down;
    float* out;
    float *MOD, *ROPE;
    bf16_t *WIN, *WV, *WA, *WB, *WOUT, *WUP, *WDOWN, *KC, *VCT, *H, *Q, *K, *VT, *P, *GATES, *ATTN, *POOLED, *MERGED, *Y, *ACT, *Z;
};

__device__ __forceinline__ int rperm(int s) { return (s & 4) ? 16 + 4 * (s >> 3) + (s & 3) : 4 * (s >> 3) + (s & 3); }
__device__ __forceinline__ void tr_item(const float* W, int ldw, int K, bf16_t* WT, int dst_row0, int src_col0, bool rp, LAS float* scr, int k0, int lane) {
#pragma unroll 8
    for (int i = 0; i < 32; ++i) { const int kk = 2 * i + (lane >> 5); scr[kk * 33 + (lane & 31)] = W[(size_t)(k0 + kk) * ldw + src_col0 + (lane & 31)]; }
    LDS_WAIT(); asm volatile("" ::: "memory");
    const int c = lane & 7;
#pragma unroll
    for (int j = 0; j < 4; ++j) { const int n = (lane >> 3) + 8 * j, sn = rp ? rperm(n) : n; const LAS float* s = scr + (8 * c) * 33 + sn;
        u32x4 o; o.x = pk2(s[0 * 33], s[1 * 33]); o.y = pk2(s[2 * 33], s[3 * 33]); o.z = pk2(s[4 * 33], s[5 * 33]); o.w = pk2(s[6 * 33], s[7 * 33]);
        *(u32x4*)(WT + (size_t)(dst_row0 + n) * K + k0 + 8 * c) = o; }
    LDS_WAIT(); asm volatile("" ::: "memory");
}
__device__ __forceinline__ void p0a(Frame& F) {
    LAS float* scr = (LAS float*)(F.lds + F.wave * 16384);
    const int gw = F.vcu * NWAVES + F.wave, NGW = F.G * NWAVES, lane = F.lane;
    constexpr int I_WIN = 16 * 112, I_WV = 16 * 16, I_WA = 8 * 32, I_WOUT = 16 * 32, I_WUP = 16 * 176, I_WDOWN = 44 * 32;
    constexpr int NITEMS = I_WIN + I_WV + I_WA + I_WOUT + I_WUP + I_WDOWN;
    for (int it = gw; it < NITEMS; it += NGW) {
        int r = it;
        if (r < I_WIN) { const int kb = r / 112, nb = r % 112; tr_item(F.w_in, INC, DM, F.WIN, 32 * nb, nb < 32 ? 32 * nb : 32 * nb + 512, nb < 32, scr, 64 * kb, lane); continue; } r -= I_WIN;
        if (r < I_WV) { const int kb = r / 16, nb = r % 16; tr_item(F.w_in, INC, DM, F.WV, 32 * nb, 1024 + 32 * nb, false, scr, 64 * kb, lane); continue; } r -= I_WV;
        if (r < I_WA) { const int kb = r / 32, nb = r % 32; tr_item(F.w_proj_a, DM, AW, F.WA, 32 * nb, 32 * nb, false, scr, 64 * kb, lane); continue; } r -= I_WA;
        if (r < I_WOUT) { const int kb = r / 32, nb = r % 32; tr_item(F.w_out, DM, DM, F.WOUT, 32 * nb, 32 * nb, false, scr, 64 * kb, lane); continue; } r -= I_WOUT;
        if (r < I_WUP) { const int kb = r / 176, nb = r % 176, pn = nb >> 3, wi = nb & 7;
            tr_item(F.w_up, 2 * FF, DM, F.WUP, 32 * nb, wi < 4 ? 128 * pn + 32 * wi : FF + 128 * pn + 32 * (wi - 4), false, scr, 64 * kb, lane); continue; } r -= I_WUP;
        { const int kb = r / 32, nb = r % 32; tr_item(F.w_down, DM, FF, F.WDOWN, 32 * nb, 32 * nb, false, scr, 64 * kb, lane); }
    }
    for (int it = F.vcu * 512 + F.tid; it < 1024 * 64; it += F.G * 512) {
        const int n = it & 1023, cc = it >> 10, c0 = 8 * cc, g = c0 >> 7;
        float a[8];
#pragma unroll
        for (int e = 0; e < 8; ++e) a[e] = 0.f;
        const float* pw = F.pool_w + (size_t)c0 * 128;
        for (int d = 0; d < 128; ++d) {
            const float wv = F.w_proj_b[(size_t)(g * 128 + d) * DM + n] * F.pool_scale[g * 128 + d];
#pragma unroll
            for (int e = 0; e < 8; ++e) a[e] += pw[e * 128 + d] * wv;
        }
        u32x4 o; o.x = pk2(a[0], a[1]); o.y = pk2(a[2], a[3]); o.z = pk2(a[4], a[5]); o.w = pk2(a[6], a[7]);
        *(u32x4*)(F.WB + (size_t)n * PW + c0) = o;
    }
    for (int it = F.vcu * 512 + F.tid; it < 128 * 16; it += F.G * 512) {
        const int pos = it >> 4, f = it & 15;
        const double bq = (f & 3) == 0 ? 1.0 : (f & 3) == 1 ? 0.5623413251903491 : (f & 3) == 2 ? 0.31622776601683794 : 0.1778279410038923;
        const double sq = (f >> 2) == 0 ? 1.0 : (f >> 2) == 1 ? 0.1 : (f >> 2) == 2 ? 0.01 : 0.001;
        const float inv = (float)(bq * sq);
        const float ang = (float)pos * inv;
        double rev = (double)ang * 0.15915494309189535; rev -= __builtin_floor(rev);
        F.ROPE[pos * 32 + f] = __builtin_amdgcn_cosf((float)rev); F.ROPE[pos * 32 + 16 + f] = __builtin_amdgcn_sinf((float)rev);
    }
    __syncthreads();
    if (F.vcu < MODW / 32) {
        LAS float* sv = (LAS float*)F.lds;
        LAS float* part = (LAS float*)(F.lds + 5 * 1024 * 4);
        for (int i = F.tid; i < 5 * 1024; i += 512) { const float v = i < 4096 ? F.c[i] : F.c_ctx[i - 4096]; sv[i] = v * pg8::sigmoid_f(v); }
        __syncthreads();
        for (int u = F.vcu; u < MODW / 32; u += F.G) {
            const int kk = lane >> 5, col = lane & 31; float a[5] = {0.f, 0.f, 0.f, 0.f, 0.f};
#pragma unroll 8
            for (int i = 0; i < 64; ++i) { const int k = 128 * F.wave + 2 * i + kk; const float wv = F.w_ada[(size_t)k * MODW + 32 * u + col];
#pragma unroll
                for (int b = 0; b < 5; ++b) a[b] += sv[b * 1024 + k] * wv; }
#pragma unroll
            for (int b = 0; b < 5; ++b) { a[b] += __shfl_xor(a[b], 32); if (lane < 32) part[(F.wave * 5 + b) * 32 + col] = a[b]; }
            __syncthreads();
            if (F.tid < 160) { const int b = F.tid >> 5, cl = F.tid & 31; float s = F.b_ada[32 * u + cl];
#pragma unroll
                for (int w = 0; w < 8; ++w) s += part[(w * 5 + b) * 32 + cl];
                F.MOD[b * MODW + 32 * u + cl] = s; }
            __syncthreads();
        }
    }
}

__device__ __forceinline__ void p0b(Frame& F) {
    const int lane = F.lane, wave = F.wave;
    for (int tt = F.vcu; tt < 256; tt += F.G) {
        const int rt = tt >> 4, ct = tt & 15, b = rt >> 2;
        const float* modc = F.MOD + 4 * MODW;
        {
            f32x4 ga[4], sh[4];
#pragma unroll
            for (int j = 0; j < 4; ++j) { const int col = 256 * j + 4 * lane; ga[j] = *(const f32x4*)(F.g_pre_mix + col) * (*(const f32x4*)(modc + 1024 + col) + 1.0f); sh[j] = *(const f32x4*)(modc + col); }
            for (int i = 0; i < 8; ++i) {
                const int lr = wave * 8 + i; const float* xr = F.ctx + (size_t)(rt * 64 + lr) * DM;
                f32x4 v[4]; float ss = 0.f;
#pragma unroll
                for (int j = 0; j < 4; ++j) { v[j] = *(const f32x4*)(xr + 256 * j + 4 * lane); ss += (v[j][0] * v[j][0] + v[j][1] * v[j][1]) + (v[j][2] * v[j][2] + v[j][3] * v[j][3]); }
                const float rstd = 1.0f / sqrtf(wave_sum(ss) * (1.0f / DM) + RMS_EPS);
#pragma unroll
                for (int j = 0; j < 4; ++j) { const f32x4 o = v[j] * rstd * ga[j] + sh[j]; u32x2 w; w.x = cvt_pk_bf16(o[0], o[1]); w.y = cvt_pk_bf16(o[2], o[3]);
                    *(LAS u32x2*)(F.lds + lr * CTXROW_B + (256 * j + 4 * lane) * 2) = w; }
            }
        }
        __syncthreads();
        {
            const int ql = lane & 15, g = lane >> 4, rowt = wave >> 1, cp = (wave & 1) * 2;
            const bool isv = ct >= 8; const int head = ct & 7;
            const bf16_t* wbase = isv ? F.WV + (size_t)(64 * head) * DM : F.WIN + (size_t)(512 + 64 * head) * DM;
            const bf16_t* w0 = wbase + (size_t)(16 * cp + ql) * DM + 8 * g; const bf16_t* w1 = w0 + (size_t)16 * DM;
            const LAS unsigned char* ap = F.lds + (16 * rowt + ql) * CTXROW_B + 16 * g;
            f32x4 acc0 = {0.f, 0.f, 0.f, 0.f}, acc1 = {0.f, 0.f, 0.f, 0.f};
#pragma unroll 4
            for (int ks = 0; ks < 32; ++ks) {
                const bf16x8 a = *(const LAS bf16x8*)(ap + ks * 64); const bf16x8 b0 = *(const bf16x8*)(w0 + ks * 32), b1 = *(const bf16x8*)(w1 + ks * 32);
                if (isv) { acc0 = __builtin_amdgcn_mfma_f32_16x16x32_bf16(a, b0, acc0, 0, 0, 0); acc1 = __builtin_amdgcn_mfma_f32_16x16x32_bf16(a, b1, acc1, 0, 0, 0); }
                else     { acc0 = __builtin_amdgcn_mfma_f32_16x16x32_bf16(b0, a, acc0, 0, 0, 0); acc1 = __builtin_amdgcn_mfma_f32_16x16x32_bf16(b1, a, acc1, 0, 0, 0); }
            }
            const size_t bh = (size_t)(b * 8 + head);
            if (isv) {
                const int j0 = (rt & 3) * 64 + 16 * rowt + 4 * g;
                u32x2 w; w.x = cvt_pk_bf16(acc0[0], acc0[1]); w.y = cvt_pk_bf16(acc0[2], acc0[3]); *(u32x2*)(F.VCT + (bh * 64 + 16 * cp + ql) * CTXL + j0) = w;
                w.x = cvt_pk_bf16(acc1[0], acc1[1]); w.y = cvt_pk_bf16(acc1[2], acc1[3]); *(u32x2*)(F.VCT + (bh * 64 + 16 * cp + 16 + ql) * CTXL + j0) = w;
            } else {
                const int j = (rt & 3) * 64 + 16 * rowt + ql;
                u32x2 w; w.x = cvt_pk_bf16(acc0[0], acc0[1]); w.y = cvt_pk_bf16(acc0[2], acc0[3]); *(u32x2*)(F.KC + (bh * CTXL + j) * 64 + 16 * cp + 4 * g) = w;
                w.x = cvt_pk_bf16(acc1[0], acc1[1]); w.y = cvt_pk_bf16(acc1[2], acc1[3]); *(u32x2*)(F.KC + (bh * CTXL + j) * 64 + 16 * cp + 16 + 4 * g) = w;
            }
        }
        __syncthreads();
    }
    const int gw = F.vcu * NWAVES + wave, NGW = F.G * NWAVES;
    for (int ch = gw; ch < M / 16; ch += NGW) {
        const float* mod = F.MOD + (ch >> 9) * MODW;
        f32x4 ga[4], sh[4];
#pragma unroll
        for (int j = 0; j < 4; ++j) { const int col = 256 * j + 4 * lane; ga[j] = *(const f32x4*)(F.g_pre_mix + col) * (*(const f32x4*)(mod + 1024 + col) + 1.0f); sh[j] = *(const f32x4*)(mod + col); }
        for (int r = 0; r < 16; ++r) {
            const size_t row = (size_t)ch * 16 + r; const float* xr = F.x + row * DM;
            f32x4 v[4]; float ss = 0.f;
#pragma unroll
            for (int j = 0; j < 4; ++j) { v[j] = *(const f32x4*)(xr + 256 * j + 4 * lane); ss += (v[j][0] * v[j][0] + v[j][1] * v[j][1]) + (v[j][2] * v[j][2] + v[j][3] * v[j][3]); }
            const float rstd = 1.0f / sqrtf(wave_sum(ss) * (1.0f / DM) + RMS_EPS);
#pragma unroll
            for (int j = 0; j < 4; ++j) { const f32x4 o = v[j] * rstd * ga[j] + sh[j]; u32x2 w; w.x = cvt_pk_bf16(o[0], o[1]); w.y = cvt_pk_bf16(o[2], o[3]);
                *(u32x2*)(F.H + row * DM + 256 * j + 4 * lane) = w; }
        }
    }
}

#define ATTN_THR 8.0f
#define ATTN_NEG (-1.0e30f)
__device__ __forceinline__ void attn_load(const bf16_t* kp, const bf16_t* vp, size_t vstride4, bf16x8 (&kf)[2][2], bf16x8 (&vf)[4]) {
    kf[0][0] = *(const bf16x8*)(kp); kf[0][1] = *(const bf16x8*)(kp + 32); kf[1][0] = *(const bf16x8*)(kp + 4 * 64); kf[1][1] = *(const bf16x8*)(kp + 4 * 64 + 32);
#pragma unroll
    for (int t = 0; t < 4; ++t) vf[t] = *(const bf16x8*)(vp + t * vstride4);
}
__device__ __forceinline__ void attn_task(Frame& F, int task) {
    const int cb = task & 3, rg = (task >> 2) & 31, bh = task >> 7, h = bh & 7;
    const int lane = F.lane, ql = lane & 15, g = lane >> 4, R = rg * 4;
    const int kcol0 = cb == 0 ? 0 : (cb == 3 ? 32 : 16 * cb - 8);
    const int keyrow = 8 * (ql >> 2) + (ql & 3), dA = 16 * (ql >> 2) + (ql & 3);
    const bf16_t* Qb = F.Q + (size_t)bh * SEQ * HD; const bf16_t* Kb = F.K + (size_t)bh * SEQ * HD; const bf16_t* VTb = F.VT + (size_t)bh * HD * SEQ;
    const bf16_t* Kcb = F.KC + (size_t)bh * CTXL * HD; const bf16_t* VcTb = F.VCT + (size_t)bh * HD * CTXL;
    bf16x8 qf[4][2]; int r0[4];
#pragma unroll
    for (int i = 0; i < 4; ++i) { const bf16_t* qp = Qb + (size_t)((R + i) * 64 + 16 * cb + ql) * HD + 8 * g; qf[i][0] = *(const bf16x8*)qp; qf[i][1] = *(const bf16x8*)(qp + 32);
        const int a = R + i - 4; r0[i] = a < 0 ? 0 : (a > 120 ? 120 : a); }
    const int krlo = r0[0], nblk = 8 + (r0[3] + 8 - r0[0]);
    const int c = 16 * cb + ql, qc0 = c - 8 < 0 ? 0 : (c - 8 > 48 ? 48 : c - 8);
    bool valid[8];
#pragma unroll
    for (int j = 0; j < 8; ++j) { const int kc = kcol0 + 8 * g + j; valid[j] = (kc >= qc0) && (kc < qc0 + 16); }
    const LAS float* bT = (const LAS float*)F.lds + h * 512 + 16 + (kcol0 - 16 * cb + 15 + 8 * g - ql);
    f32x4 o[4][4]; float mrun[4], lsum[4];
#pragma unroll
    for (int i = 0; i < 4; ++i) { mrun[i] = ATTN_NEG; lsum[i] = 0.f;
#pragma unroll
        for (int t = 0; t < 4; ++t) o[i][t] = (f32x4){0.f, 0.f, 0.f, 0.f}; }
    const bf16_t* kpc = Kcb + (size_t)keyrow * HD + 8 * g; const bf16_t* vpc = VcTb + (size_t)dA * CTXL + 8 * g;
    const bf16_t* kpw = Kb + (size_t)(kcol0 + keyrow) * HD + 8 * g; const bf16_t* vpw = VTb + (size_t)dA * SEQ + kcol0 + 8 * g;
    bf16x8 kf[2][2], vf[4], kfn[2][2], vfn[4];
    attn_load(kpc, vpc, 4 * CTXL, kf, vf);
    for (int n = 0; n < nblk; ++n) {
        const int n1 = n + 1;
        if (n1 < nblk) { if (n1 < 8) attn_load(kpc + (size_t)(32 * n1) * HD, vpc + 32 * n1, 4 * CTXL, kfn, vfn);
                         else { const int kr1 = krlo + n1 - 8; attn_load(kpw + (size_t)(kr1 * 64) * HD, vpw + kr1 * 64, 4 * SEQ, kfn, vfn); } }
        const bool win = n >= 8; const int kr = krlo + n - 8;
#pragma unroll
        for (int i = 0; i < 4; ++i) {
            const bool act = !win || (kr >= r0[i] && kr < r0[i] + 8);
            if (act) {
                f32x4 s0 = {0.f, 0.f, 0.f, 0.f}, s1 = {0.f, 0.f, 0.f, 0.f};
                s0 = __builtin_amdgcn_mfma_f32_16x16x32_bf16(kf[0][0], qf[i][0], s0, 0, 0, 0); s0 = __builtin_amdgcn_mfma_f32_16x16x32_bf16(kf[0][1], qf[i][1], s0, 0, 0, 0);
                s1 = __builtin_amdgcn_mfma_f32_16x16x32_bf16(kf[1][0], qf[i][0], s1, 0, 0, 0); s1 = __builtin_amdgcn_mfma_f32_16x16x32_bf16(kf[1][1], qf[i][1], s1, 0, 0, 0);
                float sv[8] = {s0[0], s0[1], s0[2], s0[3], s1[0], s1[1], s1[2], s1[3]};
                if (win) { const LAS float* bp = bT + (kr - (R + i) + 7) * 32;
#pragma unroll
                    for (int j = 0; j < 8; ++j) sv[j] = valid[j] ? sv[j] + bp[j] : ATTN_NEG; }
                float bm = fmaxf(fmaxf(fmaxf(sv[0], sv[1]), fmaxf(sv[2], sv[3])), fmaxf(fmaxf(sv[4], sv[5]), fmaxf(sv[6], sv[7])));
                if (__any(bm > mrun[i] + ATTN_THR)) {
                    bm = fmaxf(bm, __shfl_xor(bm, 16)); bm = fmaxf(bm, __shfl_xor(bm, 32));
                    const float mn = fmaxf(mrun[i], bm), alpha = __builtin_amdgcn_exp2f(mrun[i] - mn);
                    mrun[i] = mn; lsum[i] *= alpha;
#pragma unroll
                    for (int t = 0; t < 4; ++t) o[i][t] *= alpha;
                }
                float ps = 0.f;
#pragma unroll
                for (int j = 0; j < 8; ++j) { sv[j] = __builtin_amdgcn_exp2f(sv[j] - mrun[i]); ps += sv[j]; }
                lsum[i] += ps;
                u32x4 pw; pw.x = cvt_pk_bf16(sv[0], sv[1]); pw.y = cvt_pk_bf16(sv[2], sv[3]); pw.z = cvt_pk_bf16(sv[4], sv[5]); pw.w = cvt_pk_bf16(sv[6], sv[7]);
                const bf16x8 pf = __builtin_bit_cast(bf16x8, pw);
#pragma unroll
                for (int t = 0; t < 4; ++t) o[i][t] = __builtin_amdgcn_mfma_f32_16x16x32_bf16(vf[t], pf, o[i][t], 0, 0, 0);
            }
        }
#pragma unroll
        for (int a = 0; a < 2; ++a)
#pragma unroll
            for (int b2 = 0; b2 < 2; ++b2) kf[a][b2] = kfn[a][b2];
#pragma unroll
        for (int t = 0; t < 4; ++t) vf[t] = vfn[t];
    }
#pragma unroll
    for (int i = 0; i < 4; ++i) {
        float lt = lsum[i]; lt += __shfl_xor(lt, 16); lt += __shfl_xor(lt, 32);
        const float inv = 1.0f / lt;
        bf16_t* op = F.ATTN + (size_t)((bh >> 3) * SEQ + (R + i) * 64 + 16 * cb + ql) * AW + h * 64 + 16 * g;
        *(u32x4*)op = pack8(o[i][0] * inv, o[i][1] * inv); *(u32x4*)(op + 8) = pack8(o[i][2] * inv, o[i][3] * inv);
    }
}

#ifndef DBG_NAIVE_ATTN
#define DBG_NAIVE_ATTN 0
#endif
#if DBG_NAIVE_ATTN
__device__ __forceinline__ float bf2f(bf16_t v) { return __uint_as_float((unsigned)v << 16); }
__device__ __forceinline__ void naive_attn(Frame& F) {
    const LAS float* T = (const LAS float*)F.lds;
    for (int it = F.vcu * 512 + F.tid; it < M * NH; it += F.G * 512) {
        const int tokg = it >> 3, h = it & 7, b = tokg >> 13, t = tokg & 8191, r = t >> 6, c = t & 63;
        const size_t bh = (size_t)(b * 8 + h);
        float q[64], o[64];
#pragma unroll
        for (int d = 0; d < 64; ++d) { q[d] = bf2f(F.Q[(bh * SEQ + t) * 64 + d]); o[d] = 0.f; }
        float m = -1.0e30f, l = 0.f;
        const int r0 = r - 4 < 0 ? 0 : (r - 4 > 120 ? 120 : r - 4), c0 = c - 8 < 0 ? 0 : (c - 8 > 48 ? 48 : c - 8);
        for (int kk = 0; kk < 384; ++kk) {
            float s = 0.f; const bf16_t* kp; const bf16_t* vp; size_t vs;
            if (kk < 128) { const int kr = r0 + (kk >> 4), kc = c0 + (kk & 15); kp = F.K + (bh * SEQ + kr * 64 + kc) * 64; vp = F.VT + bh * 64 * SEQ + kr * 64 + kc; vs = SEQ;
                s = T[h * 512 + 16 + (kr - r + 7) * 32 + (kc - c + 15)]; }
            else { const int j = kk - 128; kp = F.KC + (bh * CTXL + j) * 64; vp = F.VCT + bh * 64 * CTXL + j; vs = CTXL; }
#pragma unroll
            for (int d = 0; d < 64; ++d) s += q[d] * bf2f(kp[d]);
            const float mn = fmaxf(m, s), al = __builtin_amdgcn_exp2f(m - mn), p = __builtin_amdgcn_exp2f(s - mn);
            m = mn; l = l * al + p;
#pragma unroll
            for (int d = 0; d < 64; ++d) o[d] = o[d] * al + p * bf2f(vp[(size_t)d * vs]);
        }
        const float inv = 1.0f / l;
        bf16_t* op = F.ATTN + (size_t)tokg * AW + h * 64;
#pragma unroll
        for (int d = 0; d < 64; d += 2) *(unsigned*)(op + d) = cvt_pk_bf16(o[d] * inv, o[d + 1] * inv);
    }
}
#endif
__device__ __forceinline__ void p2(Frame& F) {
    LAS float* T = (LAS float*)F.lds;
    for (int i = F.tid; i < 8 * 512; i += 512) { const int h = i >> 9, rr = (i & 511) - 16, dr = rr >> 5, dc = rr & 31;
        T[i] = (rr >= 0 && dr < 15 && dc < 31) ? F.rpb[(h * 15 + dr) * 31 + dc] * LOG2E : 0.f; }
    __syncthreads();
    const int gw = F.vcu * NWAVES + F.wave, NGW = F.G * NWAVES;
#if DBG_NAIVE_ATTN
    naive_attn(F); (void)gw; (void)NGW;
#else
    for (int pr = gw; pr < 2048; pr += NGW) { attn_task(F, 2 * pr); attn_task(F, 2 * pr + 1); }
#endif
    for (int it = F.vcu * 512 + F.tid; it < M * 64; it += F.G * 512) {
        const int row = it >> 6, chn = it & 63, t = row & (SEQ - 1), hw = 1 << (chn >> 4);
        const int lo = t - hw < 0 ? 0 : t - hw, hi = t + hw > SEQ ? SEQ : t + hw;
        const bf16_t* pb = F.P + (size_t)(row - t) * PW + 8 * chn;
        f32x4 s0 = {0.f, 0.f, 0.f, 0.f}, s1 = {0.f, 0.f, 0.f, 0.f};
        for (int tt = lo; tt < hi; ++tt) { f32x4 a, b; unpack8(*(const u32x4*)(pb + (size_t)tt * PW), a, b); s0 += a; s1 += b; }
        f32x4 a, b; unpack8(*(const u32x4*)(pb + (size_t)t * PW), a, b);
        const float ic = 1.0f / (float)(hi - lo);
        *(u32x4*)(F.POOLED + (size_t)row * PW + 8 * chn) = pack8(s0 * ic - a, s1 * ic - b);
    }
}

__device__ __forceinline__ void ld_bf16x4(const bf16_t* p, f32x4& v) { const u32x2 w = *(const u32x2*)p; v[0] = __uint_as_float(w.x << 16); v[1] = __uint_as_float(w.x & 0xffff0000u); v[2] = __uint_as_float(w.y << 16); v[3] = __uint_as_float(w.y & 0xffff0000u); }
__device__ __forceinline__ float sumsq4(const f32x4 (&v)[4]) { float ss = 0.f;
#pragma unroll
    for (int j = 0; j < 4; ++j) ss += (v[j][0] * v[j][0] + v[j][1] * v[j][1]) + (v[j][2] * v[j][2] + v[j][3] * v[j][3]);
    return ss; }
__device__ __forceinline__ void p4b(Frame& F) {
    const int lane = F.lane, gw = F.vcu * NWAVES + F.wave, NGW = F.G * NWAVES;
    for (int ch = gw; ch < M / 16; ch += NGW) {
        const float* mod = F.MOD + (ch >> 9) * MODW;
        f32x4 a1[4], a2[4], s2[4];
#pragma unroll
        for (int j = 0; j < 4; ++j) { const int col = 256 * j + 4 * lane; a1[j] = *(const f32x4*)(mod + 2048 + col) * *(const f32x4*)(F.g_post_mix + col);
            a2[j] = *(const f32x4*)(F.g_pre_ffn + col) * (*(const f32x4*)(mod + 4096 + col) + 1.0f); s2[j] = *(const f32x4*)(mod + 3072 + col); }
        for (int r = 0; r < 16; ++r) {
            const size_t row = (size_t)ch * 16 + r;
            f32x4 y[4], xv[4];
#pragma unroll
            for (int j = 0; j < 4; ++j) { ld_bf16x4(F.Y + row * DM + 256 * j + 4 * lane, y[j]); xv[j] = *(const f32x4*)(F.x + row * DM + 256 * j + 4 * lane); }
            const float rstd = 1.0f / sqrtf(wave_sum(sumsq4(y)) * (1.0f / DM) + RMS_EPS);
#pragma unroll
            for (int j = 0; j < 4; ++j) { xv[j] = xv[j] + a1[j] * (y[j] * rstd); *(f32x4*)(F.out + row * DM + 256 * j + 4 * lane) = xv[j]; }
            const float rstd2 = 1.0f / sqrtf(wave_sum(sumsq4(xv)) * (1.0f / DM) + RMS_EPS);
#pragma unroll
            for (int j = 0; j < 4; ++j) { const f32x4 o = xv[j] * rstd2 * a2[j] + s2[j]; u32x2 w; w.x = cvt_pk_bf16(o[0], o[1]); w.y = cvt_pk_bf16(o[2], o[3]);
                *(u32x2*)(F.H + row * DM + 256 * j + 4 * lane) = w; }
        }
    }
}
__device__ __forceinline__ void p6b(Frame& F) {
    const int lane = F.lane, gw = F.vcu * NWAVES + F.wave, NGW = F.G * NWAVES;
    for (int ch = gw; ch < M / 16; ch += NGW) {
        const float* mod = F.MOD + (ch >> 9) * MODW;
        f32x4 a1[4];
#pragma unroll
        for (int j = 0; j < 4; ++j) { const int col = 256 * j + 4 * lane; a1[j] = *(const f32x4*)(mod + 5120 + col) * *(const f32x4*)(F.g_post_ffn + col); }
        for (int r = 0; r < 16; ++r) {
            const size_t row = (size_t)ch * 16 + r;
            f32x4 z[4], xv[4];
#pragma unroll
            for (int j = 0; j < 4; ++j) { ld_bf16x4(F.Z + row * DM + 256 * j + 4 * lane, z[j]); xv[j] = *(const f32x4*)(F.out + row * DM + 256 * j + 4 * lane); }
            const float rstd = 1.0f / sqrtf(wave_sum(sumsq4(z)) * (1.0f / DM) + RMS_EPS);
#pragma unroll
            for (int j = 0; j < 4; ++j) *(f32x4*)(F.out + row * DM + 256 * j + 4 * lane) = xv[j] + a1[j] * (z[j] * rstd);
        }
    }
}


#ifndef DBG_NAIVE_ROWS
#define DBG_NAIVE_ROWS 0
#endif
#if DBG_NAIVE_ROWS
__device__ __forceinline__ float bf2f_(bf16_t v) { return __uint_as_float((unsigned)v << 16); }
__device__ __forceinline__ void naive_mod(Frame& F) {
    for (int it = F.vcu * 512 + F.tid; it < 5 * MODW; it += F.G * 512) {
        const int b = it / MODW, n = it % MODW; float s = 0.f;
        for (int k = 0; k < DM; ++k) { const float v = b < 4 ? F.c[b * DM + k] : F.c_ctx[k]; s += (v / (1.0f + __expf(-v))) * F.w_ada[(size_t)k * MODW + n]; }
        F.MOD[it] = s + F.b_ada[n];
    }
}
__device__ __forceinline__ void naive_p4b(Frame& F) {
    for (int row = F.vcu * 512 + F.tid; row < M; row += F.G * 512) {
        const float* mod = F.MOD + (row >> 13) * MODW; float ss = 0.f;
        for (int c = 0; c < DM; ++c) { const float y = bf2f_(F.Y[(size_t)row * DM + c]); ss += y * y; }
        const float rstd = 1.0f / sqrtf(ss / DM + RMS_EPS); float ss2 = 0.f;
        for (int c = 0; c < DM; ++c) { const float y = bf2f_(F.Y[(size_t)row * DM + c]); const float x1 = F.x[(size_t)row * DM + c] + mod[2048 + c] * (y * rstd * F.g_post_mix[c]); F.out[(size_t)row * DM + c] = x1; ss2 += x1 * x1; }
        const float rstd2 = 1.0f / sqrtf(ss2 / DM + RMS_EPS);
        for (int c = 0; c < DM; c += 2) { const float a = F.out[(size_t)row * DM + c] * rstd2 * F.g_pre_ffn[c] * (1.0f + mod[4096 + c]) + mod[3072 + c];
            const float b = F.out[(size_t)row * DM + c + 1] * rstd2 * F.g_pre_ffn[c + 1] * (1.0f + mod[4096 + c + 1]) + mod[3072 + c + 1];
            *(unsigned*)(F.H + (size_t)row * DM + c) = cvt_pk_bf16(a, b); }
    }
}
__device__ __forceinline__ void naive_p6b(Frame& F) {
    for (int row = F.vcu * 512 + F.tid; row < M; row += F.G * 512) {
        const float* mod = F.MOD + (row >> 13) * MODW; float ss = 0.f;
        for (int c = 0; c < DM; ++c) { const float z = bf2f_(F.Z[(size_t)row * DM + c]); ss += z * z; }
        const float rstd = 1.0f / sqrtf(ss / DM + RMS_EPS);
        for (int c = 0; c < DM; ++c) { const float z = bf2f_(F.Z[(size_t)row * DM + c]); F.out[(size_t)row * DM + c] = F.out[(size_t)row * DM + c] + mod[5120 + c] * (z * rstd * F.g_post_ffn[c]); }
    }
}
#endif

#ifndef DBG_CHECK
#define DBG_CHECK 0
#endif
#if DBG_CHECK
__device__ __forceinline__ void chk_rec(Frame& F, int k, float err) { atomicMax(F.ctl + 1024 + k, __float_as_uint(fabsf(err))); }
__device__ __forceinline__ float rbf(float v) { return __uint_as_float(f2bf(v) << 16); }
__device__ __forceinline__ float b2f(bf16_t v) { return __uint_as_float((unsigned)v << 16); }
__device__ __forceinline__ int srow(int i) { return 256 * i + ((37 * i + 11) & 255); }
__device__ void run_check(Frame& F, int id) {
    const long gt = (long)F.vcu * 512 + F.tid, NT = (long)F.G * 512;
    if (id == 1) {
        for (long e = gt; e < 3584L * 1024; e += NT) { const int n = (int)(e >> 10), k = (int)(e & 1023), src = n < 1024 ? ((n & ~31) + rperm(n & 31)) : n + 512; chk_rec(F, 1, (b2f(F.WIN[e]) - rbf(F.w_in[(size_t)k * 4096 + src])) / 0.03f); }
        for (long e = gt; e < 512L * 1024; e += NT) { const int n = (int)(e >> 10), k = (int)(e & 1023); chk_rec(F, 1, (b2f(F.WV[e]) - rbf(F.w_in[(size_t)k * 4096 + 1024 + n])) / 0.03f); }
        for (long e = gt; e < 1024L * 512; e += NT) { const int n = (int)(e >> 9), k = (int)(e & 511); chk_rec(F, 1, (b2f(F.WA[e]) - rbf(F.w_proj_a[(size_t)k * 1024 + n])) / 0.04f); }
        for (long e = gt; e < 1024L * 1024; e += NT) { const int n = (int)(e >> 10), k = (int)(e & 1023); chk_rec(F, 1, (b2f(F.WOUT[e]) - rbf(F.w_out[(size_t)k * 1024 + n])) / 0.03f); }
        for (long e = gt; e < 5632L * 1024; e += NT) { const int n = (int)(e >> 10), k = (int)(e & 1023), pn = n >> 8, w = n & 255, src = w < 128 ? 128 * pn + w : 2816 + 128 * pn + (w - 128);
            chk_rec(F, 1, (b2f(F.WUP[e]) - rbf(F.w_up[(size_t)k * 5632 + src])) / 0.03f); }
        for (long e = gt; e < 1024L * 2816; e += NT) { const int n = (int)(e / 2816), k = (int)(e % 2816); chk_rec(F, 1, (b2f(F.WDOWN[e]) - rbf(F.w_down[(size_t)k * 1024 + n])) / 0.02f); }
        for (long e = gt; e < 1024L * 512; e += NT) { const int n = (int)(e >> 9), kk = (int)(e & 511), g = kk >> 7; float a = 0.f;
            for (int d = 0; d < 128; ++d) a += F.pool_w[(size_t)kk * 128 + d] * (F.w_proj_b[(size_t)(g * 128 + d) * 1024 + n] * F.pool_scale[g * 128 + d]);
            chk_rec(F, 1, (b2f(F.WB[e]) - rbf(a)) / 0.04f); }
    } else if (id == 2) {
        for (long e = gt; e < 128L * 1024; e += NT) { const int row = srow((int)(e >> 10)), c = (int)(e & 1023); const float* mod = F.MOD + (row >> 13) * MODW; float ss = 0.f;
            for (int k = 0; k < 1024; ++k) { const float v = F.x[(size_t)row * 1024 + k]; ss += v * v; }
            const float rstd = 1.0f / sqrtf(ss / 1024.f + RMS_EPS), ex = (F.x[(size_t)row * 1024 + c] * rstd * F.g_pre_mix[c]) * (1.0f + mod[1024 + c]) + mod[c];
            chk_rec(F, 2, b2f(F.H[(size_t)row * 1024 + c]) - rbf(ex)); }
    } else if (id == 3) {
        for (long e = gt; e < 4L * 32 * 1024; e += NT) { const int b = (int)(e >> 15), j = 8 * (int)((e >> 10) & 31) + 3, col = (int)(e & 1023);
            const float* xr = F.ctx + (size_t)(b * 256 + j) * 1024; const float* mod = F.MOD + 4 * MODW; float ss = 0.f;
            for (int k = 0; k < 1024; ++k) ss += xr[k] * xr[k];
            const float rstd = 1.0f / sqrtf(ss / 1024.f + RMS_EPS); float a = 0.f;
            for (int k = 0; k < 1024; ++k) a += rbf((xr[k] * rstd * F.g_pre_mix[k]) * (1.0f + mod[1024 + k]) + mod[k]) * rbf(F.w_in[(size_t)k * 4096 + 512 + col]);
            const int ch = col & 511, h = ch >> 6, d = ch & 63;
            if (col < 512) { const int half = d >> 5, dd = d & 31, s = dd < 16 ? 8 * (dd >> 2) + (dd & 3) : 8 * ((dd - 16) >> 2) + 4 + (dd & 3);
                chk_rec(F, 3, b2f(F.KC[((size_t)(b * 8 + h) * 256 + j) * 64 + 32 * half + s]) - rbf(a)); }
            else chk_rec(F, 3, b2f(F.VCT[((size_t)(b * 8 + h) * 64 + d) * 256 + j]) - rbf(a)); }
    } else if (id == 4) {
        for (long e = gt; e < 128L * 4096; e += NT) { const int row = srow((int)(e >> 12)), c = (int)(e & 4095), b = row >> 13, t = row & 8191;
            const bf16_t* hr = F.H + (size_t)row * 1024;
            if (c < 1024) {
                const int cc = c & 511, h = cc >> 6, d = cc & 63, a = d >> 5, dd = d & 31; if (dd >= 16) continue; const int f = dd;
                float x1 = 0.f, x2 = 0.f; const size_t cbase = (size_t)(c < 512 ? 0 : 512) + h * 64 + a * 32;
                for (int k = 0; k < 1024; ++k) { const float hv = b2f(hr[k]); x1 += hv * rbf(F.w_in[(size_t)k * 4096 + cbase + f]); x2 += hv * rbf(F.w_in[(size_t)k * 4096 + cbase + 16 + f]); }
                const double bq = (f & 3) == 0 ? 1.0 : (f & 3) == 1 ? 0.5623413251903491 : (f & 3) == 2 ? 0.31622776601683794 : 0.1778279410038923;
                const double sq = (f >> 2) == 0 ? 1.0 : (f >> 2) == 1 ? 0.1 : (f >> 2) == 2 ? 0.01 : 0.001;
                const float ang = (float)(a ? (t & 63) : (t >> 6)) * (float)(bq * sq); double rev = (double)ang * 0.15915494309189535; rev -= __builtin_floor(rev);
                const float cs = __builtin_amdgcn_cosf((float)rev), sn = __builtin_amdgcn_sinf((float)rev), qs = c < 512 ? 0.125f * LOG2E : 1.0f;
                const float o1 = (x1 * cs - x2 * sn) * qs, o2 = (x2 * cs + x1 * sn) * qs; const int s1 = a * 32 + 8 * (f >> 2) + (f & 3);
                const bf16_t* dst = (c < 512 ? F.Q : F.K) + ((size_t)(b * 8 + h) * 8192 + t) * 64;
                chk_rec(F, c < 512 ? 4 : 5, (b2f(dst[s1]) - rbf(o1)) / (c < 512 ? 0.18f : 1.0f)); chk_rec(F, c < 512 ? 4 : 5, (b2f(dst[s1 + 4]) - rbf(o2)) / (c < 512 ? 0.18f : 1.0f));
            } else {
                float a = 0.f; for (int k = 0; k < 1024; ++k) a += b2f(hr[k]) * rbf(F.w_in[(size_t)k * 4096 + c]);
                if (c < 1536) { const int ch = c - 1024; chk_rec(F, 6, b2f(F.VT[((size_t)(b * 512 + ch)) * 8192 + t]) - rbf(a)); }
                else if (c < 2048) chk_rec(F, 7, b2f(F.P[(size_t)row * 512 + c - 1536]) - rbf(a));
                else { const float er = (b2f(F.GATES[(size_t)row * 2048 + c - 2048]) - rbf(1.0f / (1.0f + __expf(-(a + F.b_gate[c - 2048]))))) / 0.25f; if (fabsf(er) > 0.06f) atomicOr(F.ctl + 2048 + (int)(e >> 12), 1u << ((c - 2048) >> 7)); }
            } }
    } else if (id == 5) {
        for (long e = gt; e < 12288L * 2048; e += NT) { const int row = (int)(e >> 11), c = (int)(e & 2047); const float v = b2f(F.GATES[e]);
            if (!(v >= 0.0f && v <= 1.0f)) { atomicOr(F.ctl + 3000, 1u << ((row & 255) >> 4)); atomicOr(F.ctl + 3001, 1u << (c >> 7)); atomicAdd(F.ctl + 3002, 1u); } }
    } else if (id == 9) {
        for (long e = gt; e < 128L * 512; e += NT) { const int row = srow((int)(e >> 9)), c = (int)(e & 511), t = row & 8191, hw = 1 << (c >> 7), lo = t - hw < 0 ? 0 : t - hw, hi = t + hw > 8192 ? 8192 : t + hw;
            float sm = 0.f; for (int tt = lo; tt < hi; ++tt) sm += b2f(F.P[(size_t)(row - t + tt) * 512 + c]);
            chk_rec(F, 9, b2f(F.POOLED[(size_t)row * 512 + c]) - rbf(sm / (float)(hi - lo) - b2f(F.P[(size_t)row * 512 + c]))); }
    } else if (id == 10) {
        for (long e = gt; e < 128L * 1024; e += NT) { const int row = srow((int)(e >> 10)), n = (int)(e & 1023); float t1 = 0.f, t2 = 0.f;
            for (int k = 0; k < 512; ++k) { t1 += b2f(F.ATTN[(size_t)row * 512 + k]) * rbf(F.w_proj_a[(size_t)k * 1024 + n]); t2 += b2f(F.POOLED[(size_t)row * 512 + k]) * b2f(F.WB[(size_t)n * 512 + k]); }
            const float ga = b2f(F.GATES[(size_t)row * 2048 + n]), gb = b2f(F.GATES[(size_t)row * 2048 + 1024 + n]);
            chk_rec(F, 10, (b2f(F.MERGED[(size_t)row * 1024 + n]) - rbf(rbf(ga * t1) + gb * t2)) / 0.5f); }
    } else if (id == 11) {
        for (long e = gt; e < 128L * 1024; e += NT) { const int row = srow((int)(e >> 10)), n = (int)(e & 1023); float a = 0.f;
            for (int k = 0; k < 1024; ++k) a += b2f(F.MERGED[(size_t)row * 1024 + k]) * rbf(F.w_out[(size_t)k * 1024 + n]);
            chk_rec(F, 11, (b2f(F.Y[(size_t)row * 1024 + n]) - rbf(a)) / 0.5f); }
    } else if (id == 12) {
        for (long e = gt; e < 128L * 2816; e += NT) { const int row = srow((int)(e / 2816)), j = (int)(e % 2816); float g = 0.f, u = 0.f;
            for (int k = 0; k < 1024; ++k) { const float hv = b2f(F.H[(size_t)row * 1024 + k]); g += hv * rbf(F.w_up[(size_t)k * 5632 + j]); u += hv * rbf(F.w_up[(size_t)k * 5632 + 2816 + j]); }
            chk_rec(F, 12, b2f(F.ACT[(size_t)row * 2816 + j]) - rbf(g / (1.0f + __expf(-g)) * u)); }
    } else if (id == 13) {
        for (long e = gt; e < 128L * 1024; e += NT) { const int row = srow((int)(e >> 10)), n = (int)(e & 1023); float a = 0.f;
            for (int k = 0; k < 2816; ++k) a += b2f(F.ACT[(size_t)row * 2816 + k]) * rbf(F.w_down[(size_t)k * 1024 + n]);
            chk_rec(F, 13, (b2f(F.Z[(size_t)row * 1024 + n]) - rbf(a)) / 0.5f); }
    } else if (id == 99) {
        if (gt == 0) { F.out[0] = 1.0e3f * (float)F.ctl[3000]; }
    }
}
#endif
#if DBG_NAIVE_GEMM
#define GEMM_PHASE(EPI, SCHED) pg8::gemm_phase_naive<EPI, SCHED>(g, S, E)
#else
#define GEMM_PHASE(EPI, SCHED) pg8::gemm_phase<EPI, SCHED, true, true>(ring, g, S, E)
#endif
struct Args { const float* in[20]; float* out; unsigned char* ws; int ph_lo, ph_hi; };
__global__ void __launch_bounds__(NWAVES * 64, 2) fwd_megakernel(Args args) {
    extern __shared__ __attribute__((aligned(16))) unsigned char lds[];
    Frame F;
    F.lds = (LAS unsigned char*)lds;
    F.MISC = (volatile LAS unsigned*)(F.lds + MISC_OFF);
    F.tid = threadIdx.x; F.lane = F.tid & 63; F.wave = __builtin_amdgcn_readfirstlane(F.tid >> 6);
    F.G = gridDim.x; { const int bx = blockIdx.x; F.vcu = (F.G % 8 == 0) ? (bx % 8) * (F.G / 8) + bx / 8 : bx; }
    unsigned char* ws = args.ws;
    F.ctl = (unsigned*)(ws + WS_CTL);
    F.x = args.in[0]; F.c = args.in[1]; F.ctx = args.in[2]; F.c_ctx = args.in[3]; F.w_ada = args.in[4]; F.b_ada = args.in[5]; F.g_pre_mix = args.in[6]; F.g_post_mix = args.in[7];
    F.g_pre_ffn = args.in[8]; F.g_post_ffn = args.in[9]; F.w_in = args.in[10]; F.b_gate = args.in[11]; F.rpb = args.in[12]; F.pool_w = args.in[13]; F.pool_scale = args.in[14];
    F.w_proj_a = args.in[15]; F.w_proj_b = args.in[16]; F.w_out = args.in[17]; F.w_up = args.in[18]; F.w_down = args.in[19]; F.out = args.out;
    F.MOD = (float*)(ws + WS_MOD); F.ROPE = (float*)(ws + WS_ROPE);
    F.WIN = (bf16_t*)(ws + WS_WIN); F.WV = (bf16_t*)(ws + WS_WV); F.WA = (bf16_t*)(ws + WS_WA); F.WB = (bf16_t*)(ws + WS_WB); F.WOUT = (bf16_t*)(ws + WS_WOUT); F.WUP = (bf16_t*)(ws + WS_WUP); F.WDOWN = (bf16_t*)(ws + WS_WDOWN);
    F.KC = (bf16_t*)(ws + WS_KC); F.VCT = (bf16_t*)(ws + WS_VCT); F.H = (bf16_t*)(ws + WS_H); F.Q = (bf16_t*)(ws + WS_Q); F.K = (bf16_t*)(ws + WS_K); F.VT = (bf16_t*)(ws + WS_VT); F.P = (bf16_t*)(ws + WS_P);
    F.GATES = (bf16_t*)(ws + WS_GATES); F.ATTN = (bf16_t*)(ws + WS_ATTN); F.POOLED = (bf16_t*)(ws + WS_POOLED); F.MERGED = (bf16_t*)(ws + WS_MERGED); F.Y = (bf16_t*)(ws + WS_Y); F.ACT = (bf16_t*)(ws + WS_ACT); F.Z = (bf16_t*)(ws + WS_Z);
    for (int u = F.tid; u < (LDS_BYTES - LDSCTL_OFF) / 4; u += NWAVES * 64) ((LAS unsigned*)(F.lds + LDSCTL_OFF))[u] = 0u;
    __syncthreads();
    XcdBarrier bar; bar.bar = F.ctl + CW_BAR; bar.x = 0; bar.st = nullptr;
    if (N_LAUNCHES == 1) bar = xcd_barrier_post(F.ctl + CW_BAR, F.MISC + 8);
    const int lo = args.ph_lo, hi = args.ph_hi;
#if DBG_CHECK
    if (lo >= 100) { run_check(F, lo - 100); return; }
#endif
#define IN(k) (lo <= (k) && (k) < hi)
#define SEAM(k) do { if (IN(k) && IN((k) + 1)) xcd_barrier(bar); } while (0)
    LAS unsigned char* ring = F.lds;

    if (IN(0)) { p0a(F);
#if DBG_NAIVE_ROWS
      naive_mod(F);
#endif
    } SEAM(0);
    if (IN(1)) { p0b(F); } SEAM(1);
    if (IN(2)) {
        { pg8::Gemm g{F.H, F.WIN, F.H, F.WIN, M, NIN1, DM}; pg8::StaticOrder S; S.init(M, NIN1, F.G, (int)blockIdx.x);
          pg8::EpiProj E{F.Q, F.K, F.P, F.GATES, F.ROPE, F.b_gate};
          GEMM_PHASE(pg8::EpiProj, pg8::StaticOrder); }
        { pg8::Gemm g{F.WV, F.H, F.WV, F.H, AW, M, DM}; pg8::StaticOrder S; S.init(AW, M, F.G, (int)blockIdx.x);
          pg8::EpiVT E{F.VT};
          GEMM_PHASE(pg8::EpiVT, pg8::StaticOrder); }
    } SEAM(2);
    if (IN(3)) { __syncthreads(); p2(F); } SEAM(3);
    if (IN(4)) {
        pg8::Gemm g{F.ATTN, F.WA, F.POOLED, F.WB, M, DM, AW}; pg8::PairOrder S; S.S.init(M, DM, F.G, (int)blockIdx.x);
        pg8::EpiMerge E{F.GATES, F.MERGED};
        GEMM_PHASE(pg8::EpiMerge, pg8::PairOrder);
    } SEAM(4);
    if (IN(5)) {
        pg8::Gemm g{F.MERGED, F.WOUT, F.MERGED, F.WOUT, M, DM, DM}; pg8::StaticOrder S; S.init(M, DM, F.G, (int)blockIdx.x);
        pg8::EpiPlain E{F.Y, DM};
        GEMM_PHASE(pg8::EpiPlain, pg8::StaticOrder);
    } SEAM(5);
#if DBG_NAIVE_ROWS
    if (IN(6)) { naive_p4b(F); } SEAM(6);
#else
    if (IN(6)) { p4b(F); } SEAM(6);
#endif
    if (IN(7)) {
        pg8::Gemm g{F.H, F.WUP, F.H, F.WUP, M, 2 * FF, DM}; pg8::StaticOrder S; S.init(M, 2 * FF, F.G, (int)blockIdx.x);
        pg8::EpiSwiglu E{F.ACT};
        GEMM_PHASE(pg8::EpiSwiglu, pg8::StaticOrder);
    } SEAM(7);
    if (IN(8)) {
        pg8::Gemm g{F.ACT, F.WDOWN, F.ACT, F.WDOWN, M, DM, FF}; pg8::StaticOrder S; S.init(M, DM, F.G, (int)blockIdx.x);
        pg8::EpiPlain E{F.Z, DM};
        GEMM_PHASE(pg8::EpiPlain, pg8::StaticOrder);
    } SEAM(8);
#if DBG_NAIVE_ROWS
    if (IN(9)) { naive_p6b(F); }
#else
    if (IN(9)) { p6b(F); }
#endif
#undef IN
#undef SEAM
}

extern "C" void kernel_launch(void* const* d_in, const int* in_sizes, int n_in, void* d_out, int out_size, void* d_ws, size_t ws_size, hipStream_t stream) {
    static int grid = 0;
    if (grid == 0) {
        if (n_in != 20 || in_sizes[0] != M * DM || out_size != M * DM || ws_size < WS_END) {
            fprintf(stderr, "kernel_launch: built for 20 inputs, x/out of %d floats, >= %zu bytes of workspace; got n_in %d, in0 %d, out %d, ws %zu; nothing launched\n", M * DM, (size_t)WS_END, n_in, n_in > 0 ? in_sizes[0] : -1, out_size, ws_size);
            grid = -1; return; }
        int dev = 0, cus = 0, per_cu = 0;
        if (hipGetDevice(&dev) != hipSuccess || hipDeviceGetAttribute(&cus, hipDeviceAttributeMultiprocessorCount, dev) != hipSuccess) { fprintf(stderr, "kernel_launch: device query failed\n"); grid = -1; return; }
        if (hipFuncSetAttribute((const void*)fwd_megakernel, hipFuncAttributeMaxDynamicSharedMemorySize, LDS_BYTES) != hipSuccess) { fprintf(stderr, "kernel_launch: hipFuncSetAttribute failed\n"); grid = -1; return; }
        if (hipOccupancyMaxActiveBlocksPerMultiprocessor(&per_cu, (const void*)fwd_megakernel, NWAVES * 64, LDS_BYTES) != hipSuccess || per_cu < 1) {
            fprintf(stderr, "kernel_launch: occupancy query reports %d workgroups per CU for %d bytes of LDS\n", per_cu, LDS_BYTES); }
        (void)hipGetLastError();
        grid = cus;
    }
    if (grid < 0) return;
#if DBG_ZERO_ALL
    (void)hipMemsetAsync((char*)d_ws, 0, WS_END, stream); (void)hipMemsetAsync(d_out, 0, (size_t)out_size * 4, stream);
#endif
    if (hipMemsetAsync((char*)d_ws + WS_CTL, 0, CTL_ZERO_BYTES, stream) != hipSuccess) { fprintf(stderr, "kernel_launch: memset failed\n"); return; }
    Args a{};
    for (int i = 0; i < 20; ++i) a.in[i] = (const float*)d_in[i];
    a.out = (float*)d_out; a.ws = (unsigned char*)d_ws;
#if DBG_CHECK
    static const int seq[] = {0, 101, 1, 102, 103, 2, 104, 105, 3, 109, 4, 110, 5, 111, 6, 7, 112, 8, 113, 9, 199};
    const int nseq = (int)(sizeof(seq) / sizeof(seq[0]));
#else
    const int nseq = N_LAUNCHES;
#endif
    for (int li = 0; li < nseq; ++li) {
#if DBG_CHECK
        a.ph_lo = seq[li]; a.ph_hi = seq[li] + 1;
#else
        a.ph_lo = (N_LAUNCHES == 1) ? 0 : li; a.ph_hi = (N_LAUNCHES == 1) ? N_PHASES : li + 1;
#endif
        hipLaunchKernelGGL(fwd_megakernel, dim3(grid), dim3(NWAVES * 64), LDS_BYTES, stream, a);
        const hipError_t le = hipPeekAtLastError();
        if (le != hipSuccess) { fprintf(stderr, "kernel_launch: launch %d failed: %s\n", li, hipGetErrorName(le)); break; }
    }
}
```
